# Optimizing an MI355X kernel written in HIP

```python
import math
import jax, jax.numpy as jnp
from jax import lax
import numpy as np

D_MODEL = 1024
BATCH = 8
SEQ = 2048
DEPTH = 1

D_RNN = 1024
RNN_BLOCKS = 16
RNN_BLOCK_DIM = D_RNN // RNN_BLOCKS
CONV_WIDTH = 4
LRU_C = 8.0
N_HEADS = 16
HEAD_DIM = 64
N_KV_GROUPS = 4
HEADS_PER_GROUP = N_HEADS // N_KV_GROUPS
Q_DIM = N_HEADS * HEAD_DIM
KV_DIM = N_KV_GROUPS * HEAD_DIM
CMP_BLOCK = 32
CMP_STRIDE = 16
CMP_HIDDEN = 256
SEL_BLOCK = 64
SEL_TOPN = 16
WINDOW = 512
Q_BLOCK = 128
SEL_Q_CHUNK = 32
ROPE_THETA = 10000.0
FORCE_BONUS = 1e4
NEG_INF = -1e30
N_GROUPS = 4
EXPERTS_PER_GROUP = 4
N_EXPERTS = N_GROUPS * EXPERTS_PER_GROUP
TOP_K_IN_GROUP = 2
D_EXPERT = 512
EPS = 1e-6
IN_DIM = 2 * D_RNN + Q_DIM + 6 * KV_DIM + 3 * N_HEADS + 2 * D_MODEL

kernel_name = "hybrid_rglru_nsa_hiermoe"


def _split_points():
    sizes = [D_RNN, D_RNN, Q_DIM] + [KV_DIM] * 6 + [3 * N_HEADS, 2 * D_MODEL]
    return tuple(int(v) for v in np.cumsum(sizes)[:-1])


def rmsnorm(x, g):
    x32 = x.astype(jnp.float32)
    y = x32 * lax.rsqrt(jnp.mean(x32 * x32, axis=-1, keepdims=True) + EPS)
    return y.astype(x.dtype) * g


def rope_tables(pos):
    inv_freq = ROPE_THETA ** (-(jnp.arange(0, HEAD_DIM, 2, dtype=jnp.float32) / HEAD_DIM))
    ang = pos.astype(jnp.float32)[:, None] * inv_freq[None, :]
    return jnp.cos(ang), jnp.sin(ang)


def apply_rope(x, cos, sin):
    x1, x2 = jnp.split(x, 2, axis=-1)
    c = cos[None, :, None, :].astype(x.dtype)
    s = sin[None, :, None, :].astype(x.dtype)
    return jnp.concatenate([x1 * c - x2 * s, x2 * c + x1 * s], axis=-1)


def causal_depthwise_conv(x, w, b):
    y = lax.conv_general_dilated(x, w[:, None, :], window_strides=(1,),
                                 padding=[(CONV_WIDTH - 1, 0)],
                                 dimension_numbers=('NWC', 'WIO', 'NWC'),
                                 feature_group_count=x.shape[-1])
    return y + b


def rg_lru(x, w_a, b_a, w_i, b_i, lam):
    B, S, _ = x.shape
    xb = x.reshape(B, S, RNN_BLOCKS, RNN_BLOCK_DIM)
    r = jax.nn.sigmoid(jnp.einsum('bshi,hij->bshj', xb, w_a).reshape(B, S, D_RNN) + b_a)
    i = jax.nn.sigmoid(jnp.einsum('bshi,hij->bshj', xb, w_i).reshape(B, S, D_RNN) + b_i)
    log_a = -LRU_C * r.astype(jnp.float32) * jax.nn.softplus(-lam.astype(jnp.float32))
    a = jnp.exp(log_a)
    u = jnp.sqrt(-jnp.expm1(2.0 * log_a)) * (i * x).astype(jnp.float32)

    def combine(c1, c2):
        a1, b1 = c1
        a2, b2 = c2
        return a1 * a2, a2 * b1 + b2

    _, h = lax.associative_scan(combine, (a, u), axis=1)
    return h.astype(x.dtype)


def compress_blocks(k, pos_emb, w1, b1, w2, b2):
    B, S = k.shape[:2]
    n_cmp = (S - CMP_BLOCK) // CMP_STRIDE + 1
    idx = np.arange(n_cmp)[:, None] * CMP_STRIDE + np.arange(CMP_BLOCK)[None, :]
    blocks = k[:, idx] + pos_emb[None, None, :, None, :]
    blocks = blocks.transpose(0, 1, 3, 2, 4).reshape(B, n_cmp, N_KV_GROUPS, CMP_BLOCK * HEAD_DIM)
    hid = jax.nn.gelu(blocks @ w1 + b1)
    return hid @ w2 + b2


def _cmp_to_sel_matrix(n_cmp, n_sel):
    c0 = np.arange(n_cmp) * CMP_STRIDE
    s0 = np.arange(n_sel) * SEL_BLOCK
    ov = np.minimum(c0[:, None] + CMP_BLOCK, s0[None, :] + SEL_BLOCK) - np.maximum(c0[:, None], s0[None, :])
    return (np.clip(ov, 0, None) / CMP_BLOCK).astype(np.float32)


def selected_attention(qg, ks, vs, sel_idx, scale):
    B, S = qg.shape[:2]
    n_sel = S // SEL_BLOCK
    n_top = sel_idx.shape[-1]
    kb = ks.reshape(B, n_sel, SEL_BLOCK, N_KV_GROUPS, HEAD_DIM).transpose(0, 3, 1, 2, 4)
    vb = vs.reshape(B, n_sel, SEL_BLOCK, N_KV_GROUPS, HEAD_DIM).transpose(0, 3, 1, 2, 4)
    nc = S // SEL_Q_CHUNK
    qc = jnp.moveaxis(qg.reshape(B, nc, SEL_Q_CHUNK, N_KV_GROUPS, HEADS_PER_GROUP, HEAD_DIM), 1, 0)
    ic = jnp.moveaxis(sel_idx.reshape(B, N_KV_GROUPS, nc, SEL_Q_CHUNK, n_top), 2, 0)
    b_ix = jnp.arange(B)[:, None, None, None]
    g_ix = jnp.arange(N_KV_GROUPS)[None, :, None, None]
    n_keys = n_top * SEL_BLOCK

    def one_chunk(args):
        c, q_c, idx_c = args
        k_sel = kb[b_ix, g_ix, idx_c].reshape(B, N_KV_GROUPS, SEL_Q_CHUNK, n_keys, HEAD_DIM)
        v_sel = vb[b_ix, g_ix, idx_c].reshape(B, N_KV_GROUPS, SEL_Q_CHUNK, n_keys, HEAD_DIM)
        kpos = (idx_c[..., None] * SEL_BLOCK + jnp.arange(SEL_BLOCK)).reshape(B, N_KV_GROUPS, SEL_Q_CHUNK, n_keys)
        qpos = c * SEL_Q_CHUNK + jnp.arange(SEL_Q_CHUNK)
        mask = kpos <= qpos[None, None, :, None]
        s = jnp.einsum('bqghd,bgqkd->bghqk', q_c, k_sel).astype(jnp.float32) * scale
        s = jnp.where(mask[:, :, None], s, NEG_INF)
        p = jax.nn.softmax(s, axis=-1)
        return jnp.einsum('bghqk,bgqkd->bqghd', p.astype(v_sel.dtype), v_sel)

    out = lax.map(one_chunk, (jnp.arange(nc), qc, ic))
    return jnp.moveaxis(out, 0, 1).reshape(B, S, N_KV_GROUPS, HEADS_PER_GROUP, HEAD_DIM)


def window_attention(qg, kw, vw, scale):
    B, S = qg.shape[:2]
    nb = S // Q_BLOCK
    span = WINDOW + Q_BLOCK
    kpad = jnp.pad(kw, ((0, 0), (WINDOW, 0), (0, 0), (0, 0)))
    vpad = jnp.pad(vw, ((0, 0), (WINDOW, 0), (0, 0), (0, 0)))
    qb = jnp.moveaxis(qg.reshape(B, nb, Q_BLOCK, N_KV_GROUPS, HEADS_PER_GROUP, HEAD_DIM), 1, 0)

    def one_block(args):
        i, q_blk = args
        start = i * Q_BLOCK
        k_blk = lax.dynamic_slice_in_dim(kpad, start, span, axis=1)
        v_blk = lax.dynamic_slice_in_dim(vpad, start, span, axis=1)
        qpos = start + jnp.arange(Q_BLOCK)
        kpos = start - WINDOW + jnp.arange(span)
        d = qpos[:, None] - kpos[None, :]
        mask = (kpos[None, :] >= 0) & (d >= 0) & (d < WINDOW)
        s = jnp.einsum('bqghd,bkgd->bghqk', q_blk, k_blk).astype(jnp.float32) * scale
        s = jnp.where(mask, s, NEG_INF)
        p = jax.nn.softmax(s, axis=-1)
        return jnp.einsum('bghqk,bkgd->bqghd', p.astype(v_blk.dtype), v_blk)

    out = lax.map(one_block, (jnp.arange(nb), qb))
    return jnp.moveaxis(out, 0, 1).reshape(B, S, N_KV_GROUPS, HEADS_PER_GROUP, HEAD_DIM)


def nsa_attention(q, kc, vc, ks, vs, kw, vw, gates, cos, sin,
                  cmpk_pos, cmpk_w1, cmpk_b1, cmpk_w2, cmpk_b2,
                  cmpv_pos, cmpv_w1, cmpv_b1, cmpv_w2, cmpv_b2):
    B, S = q.shape[:2]
    scale = HEAD_DIM ** -0.5
    q = apply_rope(q.reshape(B, S, N_HEADS, HEAD_DIM), cos, sin)
    qg = q.reshape(B, S, N_KV_GROUPS, HEADS_PER_GROUP, HEAD_DIM)
    kv = lambda t: t.reshape(B, S, N_KV_GROUPS, HEAD_DIM)
    kc, vc, ks, vs, kw, vw = kv(kc), kv(vc), kv(ks), kv(vs), kv(kw), kv(vw)
    ks = apply_rope(ks, cos, sin)
    kw = apply_rope(kw, cos, sin)

    n_cmp = (S - CMP_BLOCK) // CMP_STRIDE + 1
    kcmp = compress_blocks(kc, cmpk_pos, cmpk_w1, cmpk_b1, cmpk_w2, cmpk_b2)
    vcmp = compress_blocks(vc, cmpv_pos, cmpv_w1, cmpv_b1, cmpv_w2, cmpv_b2)
    ends = np.arange(n_cmp) * CMP_STRIDE + CMP_BLOCK - 1
    ccos, csin = rope_tables(jnp.asarray(ends))
    kcmp = apply_rope(kcmp, ccos, csin)
    valid = ends[None, :] <= np.arange(S)[:, None]
    s = jnp.einsum('bsghd,bngd->bghsn', qg, kcmp).astype(jnp.float32) * scale
    s = jnp.where(valid, s, NEG_INF)
    p = jax.nn.softmax(s, axis=-1)
    p = jnp.where(valid.any(axis=-1)[:, None], p, 0.0)
    o_cmp = jnp.einsum('bghsn,bngd->bsghd', p.astype(vcmp.dtype), vcmp)

    n_sel = S // SEL_BLOCK
    n_top = min(SEL_TOPN, n_sel)
    p_slc = jnp.einsum('bgsn,nm->bgsm', p.sum(axis=2), _cmp_to_sel_matrix(n_cmp, n_sel))
    tblk = np.arange(S)[:, None] // SEL_BLOCK
    blk = np.arange(n_sel)[None, :]
    allowed = blk <= tblk
    forced = (blk == 0) | (blk == tblk) | (blk == tblk - 1)
    score = jnp.where(allowed, p_slc + jnp.where(forced, FORCE_BONUS, 0.0), -1.0)
    _, sel_idx = lax.top_k(score, n_top)
    o_sel = selected_attention(qg, ks, vs, sel_idx, scale)

    o_win = window_attention(qg, kw, vw, scale)

    g = jax.nn.sigmoid(gates).reshape(B, S, 3, N_KV_GROUPS, HEADS_PER_GROUP)[..., None]
    o = g[:, :, 0] * o_cmp + g[:, :, 1] * o_sel + g[:, :, 2] * o_win
    return o.reshape(B, S, Q_DIM)


def hier_moe(h, rg_w, rg_b, re_w, re_b, w_gate, w_up, w_down):
    B, S, D = h.shape
    ht = h.reshape(B * S, D)
    gp = jax.nn.softmax((ht @ rg_w + rg_b).astype(jnp.float32), axis=-1)
    g_w, g_idx = lax.top_k(gp, 1)
    g_idx = g_idx[:, 0]
    el = jnp.einsum('td,gde->tge', ht, re_w) + re_b
    el_sel = jnp.einsum('tg,tge->te', jax.nn.one_hot(g_idx, N_GROUPS, dtype=el.dtype), el)
    ep = jax.nn.softmax(el_sel.astype(jnp.float32), axis=-1)
    top_w, top_i = lax.top_k(ep, TOP_K_IN_GROUP)
    top_w = top_w / jnp.sum(top_w, axis=-1, keepdims=True)
    ids = g_idx[:, None] * EXPERTS_PER_GROUP + top_i
    comb = jnp.einsum('tk,tke->te', g_w * top_w,
                      jax.nn.one_hot(ids, N_EXPERTS, dtype=jnp.float32)).astype(ht.dtype)
    y = jnp.zeros_like(ht)
    for e in range(N_EXPERTS):
        y = y + comb[:, e:e + 1] * ((jax.nn.silu(ht @ w_gate[e]) * (ht @ w_up[e])) @ w_down[e])
    return y.reshape(B, S, D)


def setup_inputs(seed: int = 0) -> dict:
    key = jax.random.key(seed)
    ks = iter(jax.random.split(key, 40))
    L = DEPTH
    nrm = lambda shape, fan_in: jax.random.normal(next(ks), shape, jnp.float32) * fan_in ** -0.5
    gain = lambda shape: 1.0 + 0.01 * jax.random.normal(next(ks), shape, jnp.float32)
    bias = lambda shape: 0.01 * jax.random.normal(next(ks), shape, jnp.float32)
    a_c = jax.random.uniform(next(ks), (L, D_RNN), jnp.float32, 0.9, 0.999)
    a0 = a_c ** (1.0 / LRU_C)
    return {
        "x": jax.random.normal(next(ks), (BATCH, SEQ, D_MODEL), jnp.float32),
        "norm1_g": gain((L, D_MODEL)),
        "w_in": nrm((L, D_MODEL, IN_DIM), D_MODEL),
        "conv_w": nrm((L, CONV_WIDTH, D_RNN), CONV_WIDTH),
        "conv_b": bias((L, D_RNN)),
        "lru_wa": nrm((L, RNN_BLOCKS, RNN_BLOCK_DIM, RNN_BLOCK_DIM), RNN_BLOCK_DIM),
        "lru_ba": bias((L, D_RNN)),
        "lru_wi": nrm((L, RNN_BLOCKS, RNN_BLOCK_DIM, RNN_BLOCK_DIM), RNN_BLOCK_DIM),
        "lru_bi": bias((L, D_RNN)),
        "lru_lambda": jnp.log(a0) - jnp.log1p(-a0),
        "w_rnn_out": nrm((L, D_RNN, D_MODEL), D_RNN),
        "cmpk_pos": 0.02 * jax.random.normal(next(ks), (L, CMP_BLOCK, HEAD_DIM), jnp.float32),
        "cmpk_w1": nrm((L, CMP_BLOCK * HEAD_DIM, CMP_HIDDEN), CMP_BLOCK * HEAD_DIM),
        "cmpk_b1": bias((L, CMP_HIDDEN)),
        "cmpk_w2": nrm((L, CMP_HIDDEN, HEAD_DIM), CMP_HIDDEN),
        "cmpk_b2": bias((L, HEAD_DIM)),
        "cmpv_pos": 0.02 * jax.random.normal(next(ks), (L, CMP_BLOCK, HEAD_DIM), jnp.float32),
        "cmpv_w1": nrm((L, CMP_BLOCK * HEAD_DIM, CMP_HIDDEN), CMP_BLOCK * HEAD_DIM),
        "cmpv_b1": bias((L, CMP_HIDDEN)),
        "cmpv_w2": nrm((L, CMP_HIDDEN, HEAD_DIM), CMP_HIDDEN),
        "cmpv_b2": bias((L, HEAD_DIM)),
        "w_nsa_out": nrm((L, Q_DIM, D_MODEL), Q_DIM),
        "w_mix_out": nrm((L, D_MODEL, D_MODEL), D_MODEL),
        "norm2_g": gain((L, D_MODEL)),
        "router_group_w": nrm((L, D_MODEL, N_GROUPS), D_MODEL),
        "router_group_b": bias((L, N_GROUPS)),
        "router_expert_w": nrm((L, N_GROUPS, D_MODEL, EXPERTS_PER_GROUP), D_MODEL),
        "router_expert_b": bias((L, N_GROUPS, EXPERTS_PER_GROUP)),
        "expert_w_gate": nrm((L, N_EXPERTS, D_MODEL, D_EXPERT), D_MODEL),
        "expert_w_up": nrm((L, N_EXPERTS, D_MODEL, D_EXPERT), D_MODEL),
        "expert_w_down": nrm((L, N_EXPERTS, D_EXPERT, D_MODEL), D_EXPERT),
        "final_norm_g": gain((D_MODEL,)),
    }


def reference(x, norm1_g, w_in, conv_w, conv_b, lru_wa, lru_ba, lru_wi, lru_bi, lru_lambda,
              w_rnn_out, cmpk_pos, cmpk_w1, cmpk_b1, cmpk_w2, cmpk_b2,
              cmpv_pos, cmpv_w1, cmpv_b1, cmpv_w2, cmpv_b2, w_nsa_out, w_mix_out, norm2_g,
              router_group_w, router_group_b, router_expert_w, router_expert_b,
              expert_w_gate, expert_w_up, expert_w_down, final_norm_g):
    B, S, _ = x.shape
    cos, sin = rope_tables(jnp.arange(S))
    splits = _split_points()
    for l in range(DEPTH):
        h = rmsnorm(x, norm1_g[l])
        proj = h @ w_in[l]
        xr, gr, q, kc, vc, ksl, vsl, kw, vw, nsa_g, merge_g = jnp.split(proj, splits, axis=-1)
        hr = rg_lru(causal_depthwise_conv(xr, conv_w[l], conv_b[l]),
                    lru_wa[l], lru_ba[l], lru_wi[l], lru_bi[l], lru_lambda[l])
        y_a = (jax.nn.gelu(gr) * hr) @ w_rnn_out[l]
        o_nsa = nsa_attention(q, kc, vc, ksl, vsl, kw, vw, nsa_g, cos, sin,
                              cmpk_pos[l], cmpk_w1[l], cmpk_b1[l], cmpk_w2[l], cmpk_b2[l],
                              cmpv_pos[l], cmpv_w1[l], cmpv_b1[l], cmpv_w2[l], cmpv_b2[l])
        y_b = o_nsa @ w_nsa_out[l]
        g_a, g_b = jnp.split(jax.nn.sigmoid(merge_g), 2, axis=-1)
        x = x + (g_a * y_a + g_b * y_b) @ w_mix_out[l]
        h2 = rmsnorm(x, norm2_g[l])
        x = x + hier_moe(h2, router_group_w[l], router_group_b[l], router_expert_w[l],
                         router_expert_b[l], expert_w_gate[l], expert_w_up[l], expert_w_down[l])
    return rmsnorm(x, final_norm_g)
```

```cpp
#include <hip/hip_runtime.h>
#include <hip/hip_cooperative_groups.h>
#include <cstdio>
#include <cstdint>
#include <cmath>
#ifndef MK_COOP
#define MK_COOP 1
#endif

#define LAS __attribute__((address_space(3)))
#define GAS __attribute__((address_space(1)))
namespace mk {
typedef unsigned short bf16_t;
typedef short bf16x8 __attribute__((ext_vector_type(8)));
typedef float f32x4 __attribute__((ext_vector_type(4)));
typedef float f32x2 __attribute__((ext_vector_type(2)));
typedef float f32x16 __attribute__((ext_vector_type(16)));
typedef unsigned u32x4 __attribute__((ext_vector_type(4)));
typedef unsigned u32x2 __attribute__((ext_vector_type(2)));

constexpr int T = 16384, S = 2048, NB = 8, D = 1024;
constexpr size_t MiB = 1u << 20;
constexpr size_t WS_GCNT = 0;
constexpr size_t WS_RDY3 = 1024;
constexpr size_t WS_RDY = 2 * 1024;
constexpr size_t WS_RDY2 = 12 * 1024;
constexpr size_t WS_BAR = 16 * 1024;
constexpr size_t WS_RDY4 = 30 * 1024 + 512;
constexpr size_t WS_TOKW = 64 * 1024;
constexpr size_t WS_LIST = 256 * 1024;
constexpr size_t WS_AGG = 2 * MiB;
constexpr size_t WS_KCMP = 3 * MiB, WS_VCMP = 3 * MiB + 512 * 1024;
constexpr size_t WS_CS = 4 * MiB;
constexpr size_t WS_MISC = 4 * MiB + 512 * 1024;
constexpr size_t WS_WRS = 5 * MiB;
constexpr size_t WS_WRNT = 8 * MiB, WS_WMT = 12 * MiB, WS_W1TK = 14 * MiB, WS_W1TV = 15 * MiB, WS_W2T = 16 * MiB, WS_WAIT = 16 * MiB + 256 * 1024;
constexpr size_t WS_WINT = 18 * MiB;
constexpr size_t WS_XR = 32 * MiB, WS_GG = 64 * MiB, WS_Q = 96 * MiB, WS_KV = 128 * MiB, WS_MG = 176 * MiB, WS_NG = 240 * MiB;
constexpr size_t WS_M = WS_XR, WS_H2 = WS_GG, WS_WDT = 160 * MiB, WS_ACT = WS_MG, WS_Y0 = WS_Q, WS_Y1 = WS_XR;
constexpr int ACT_ROWS = 36864;
constexpr size_t WS_X1B = 212 * MiB;

constexpr int LDS_BYTES = 163840;

__device__ __forceinline__ unsigned f2bf(float f) { unsigned u = __builtin_bit_cast(unsigned, f); return (u + 0x7fffu + ((u >> 16) & 1u)) >> 16; }
typedef __bf16 bf16x2_hw __attribute__((ext_vector_type(2)));
__device__ __forceinline__ unsigned pk2(float lo, float hi) { const f32x2 v = {lo, hi}; const bf16x2_hw b = __builtin_convertvector(v, bf16x2_hw); return __builtin_bit_cast(unsigned, b); }
__device__ __forceinline__ void store16_wt(void* p, const u32x4& v) { asm volatile("global_store_dwordx4 %0, %1, off sc1\n\ts_nop 1" :: "v"(p), "v"(v) : "memory"); }
__device__ __forceinline__ float bf2f(unsigned short b) { return __builtin_bit_cast(float, (unsigned)b << 16); }
__device__ __forceinline__ float wave_sum(float v) {
#pragma unroll
    for (int o = 1; o < 64; o <<= 1) v += __shfl_xor(v, o);
    return v;
}
template <int CTRL, int ROWMASK> __device__ __forceinline__ float dpp_term(float v) { return __builtin_bit_cast(float, __builtin_amdgcn_update_dpp(0, __builtin_bit_cast(int, v), CTRL, ROWMASK, 0xf, false)); }
__device__ __forceinline__ float wave_sum_dpp(float v) {
    v += dpp_term<0xB1, 0xf>(v);
    v += dpp_term<0x4E, 0xf>(v);
    v += dpp_term<0x141, 0xf>(v);
    v += dpp_term<0x140, 0xf>(v);
    v += dpp_term<0x142, 0xa>(v);
    v += dpp_term<0x143, 0xc>(v);
    return __builtin_bit_cast(float, __builtin_amdgcn_readlane(__builtin_bit_cast(int, v), 63));
}

constexpr int BM = 256, BK = 64, HALF = 128, HTB = HALF * BK * 2, STAGE_BYTES = 8 * HTB;
constexpr int GOFF_OFF = STAGE_BYTES + 1024;
__device__ __forceinline__ int lds_byte(int r, int c) { const int st = (r >> 4) * 2 + (c >> 5), rr = r & 15, cc = c & 31, ob = rr * 64 + cc * 2; return st * 1024 + (ob ^ (((ob >> 9) & 1) << 5)); }
__device__ __forceinline__ void stage_rc(int b, int& R, int& C) { const int st = b / 1024, sb = b % 1024, swz = sb ^ (((sb >> 9) & 1) << 5); R = (st >> 1) * 16 + swz / 64; C = (st & 1) * 32 + (swz % 64) / 2; }
__device__ __forceinline__ int perm32(int rho) { const int n = rho >> 4, i = rho & 15; return 8 * (i >> 2) + 4 * n + (i & 3); }

struct Unit { int pm, pn, e, r0; };

template <class Epi, class Sched, class AOff, bool ALIGN_EPI>
__device__ __forceinline__ void gemm_phase(LAS unsigned char* lds, const bf16_t* Aptr, const bf16_t* Bt, const int K, const Sched& S, const Epi& E, const AOff& AO) {
    const int tid = threadIdx.x, wid = __builtin_amdgcn_readfirstlane(tid >> 6), lane = tid & 63, wr = wid >> 2, wc = wid & 3, fr = lane & 15, fq = lane >> 4;
    const int nt = K / BK;
    unsigned voffB[2];
#pragma unroll
    for (int i = 0; i < 2; ++i) { int R, C; stage_rc(tid * 16 + i * 8192, R, C); const int Rb = Epi::PERM ? ((R & ~31) + perm32(R & 31)) : R; voffB[i] = (unsigned)(Rb * K + C) * 2u; }
    const size_t kstep = (size_t)(BK * 2);
    const size_t hstep = (size_t)HALF * K * 2;
    const size_t tstep = 2 * hstep;
    const unsigned ldsw = (unsigned)wid * 1024u;
    const int aoff = lds_byte(wr * 64 + fr, fq * 8), boff = lds_byte(wc * 32 + fr, fq * 8);
    const char* const Abase = (const char*)Aptr;
#define PG8_SA(b, h) (((b) * 2 + (h)) * HTB)
#define PG8_SB(b, h) ((4 + (b) * 2 + (h)) * HTB)
#define PG8_STAGE(bufoff, gbase, voff) do { _Pragma("unroll") for (int _i = 0; _i < 2; ++_i) \
        __builtin_amdgcn_global_load_lds((const unsigned*)((const char*)(gbase) + (voff)[_i]), (LAS unsigned*)(lds + (bufoff) + ldsw + _i * 8192), 16, 0, 0); } while (0)
#define PG8_LDA(dst, b, h) do { _Pragma("unroll") for (int m = 0; m < 4; ++m) _Pragma("unroll") for (int k = 0; k < 2; ++k) dst[m][k] = *(const LAS bf16x8*)(lds + PG8_SA(b, h) + aoff + m * 2048 + k * 1024); } while (0)
#define PG8_LDB(dst, b, h) do { _Pragma("unroll") for (int n = 0; n < 2; ++n) _Pragma("unroll") for (int k = 0; k < 2; ++k) dst[n][k] = *(const LAS bf16x8*)(lds + PG8_SB(b, h) + boff + n * 2048 + k * 1024); } while (0)
#define PG8_MMA(ai, bj, At, Bt_) do { __builtin_amdgcn_s_setprio(1); _Pragma("unroll") for (int m = 0; m < 4; ++m) _Pragma("unroll") for (int n = 0; n < 2; ++n) _Pragma("unroll") for (int k = 0; k < 2; ++k) \
        acc[ai][bj][m][n] = __builtin_amdgcn_mfma_f32_16x16x32_bf16(Bt_[n][k], At[m][k], acc[ai][bj][m][n], 0, 0, 0); __builtin_amdgcn_s_setprio(0); } while (0)
#define PG8_WAIT_V(n) asm volatile("s_waitcnt vmcnt(" #n ")" ::: "memory")
#define PG8_WAIT_L(n) asm volatile("s_waitcnt lgkmcnt(" #n ")" ::: "memory")
#define PG8_BAR __builtin_amdgcn_s_barrier()
#define PG8_SCHED __builtin_amdgcn_sched_barrier(0)
#define PG8_AOFFS(dst, unit) do { _Pragma("unroll") for (int _i = 0; _i < 2; ++_i) { int R_, C_; stage_rc(tid * 16 + _i * 8192, R_, C_); \
        dst[0][_i] = AO(unit, 0, R_) + (unsigned)(C_ * 2); dst[1][_i] = AO(unit, 1, R_) + (unsigned)(C_ * 2); } } while (0)
    Unit cur, nxt; int ui = 0;
    if (!S.next(0, cur)) return;
    f32x4 acc[2][2][4][2];
#pragma unroll
    for (int a = 0; a < 2; ++a)
#pragma unroll
        for (int b = 0; b < 2; ++b)
#pragma unroll
            for (int m = 0; m < 4; ++m)
#pragma unroll
                for (int n = 0; n < 2; ++n) acc[a][b][m][n] = (f32x4){0.f, 0.f, 0.f, 0.f};
    bf16x8 At[4][2], B0[2][2], B1[2][2];
    unsigned ac[2][2], an[2][2];
    S.a_ready(cur);
    PG8_AOFFS(ac, cur);
    const char* cB = (const char*)Bt + (size_t)cur.pn * tstep;
    PG8_STAGE(PG8_SB(0, 0), cB, voffB); PG8_STAGE(PG8_SB(0, 1), cB + hstep, voffB); PG8_STAGE(PG8_SA(0, 0), Abase, ac[0]); PG8_STAGE(PG8_SA(0, 1), Abase, ac[1]);
    if (wr == 1) PG8_BAR;
    PG8_WAIT_V(2); PG8_BAR;
    PG8_STAGE(PG8_SB(1, 0), cB + kstep, voffB); PG8_STAGE(PG8_SA(1, 0), Abase + kstep, ac[0]); PG8_STAGE(PG8_SB(1, 1), cB + hstep + kstep, voffB);
    PG8_WAIT_V(6); PG8_BAR;
    for (;;) {
        const bool has_next = S.next(ui + 1, nxt);
        if (!has_next) nxt = cur;
        const char* nB = (const char*)Bt + (size_t)nxt.pn * tstep;
        for (int t = 0; t < nt; t += 2) {
            const bool last = (t == nt - 2);
            if (last) { if (has_next) S.a_ready(nxt); PG8_AOFFS(an, nxt); }
            const char* a1 = Abase + (size_t)(t + 1) * kstep;
            const char* a2 = last ? Abase : Abase + (size_t)(t + 2) * kstep; const char* b2 = last ? nB : cB + (size_t)(t + 2) * kstep;
            const char* a3 = a2 + kstep; const char* b3 = b2 + kstep;
            unsigned o2[2][2];
#pragma unroll
            for (int h = 0; h < 2; ++h)
#pragma unroll
                for (int i = 0; i < 2; ++i) o2[h][i] = last ? an[h][i] : ac[h][i];
            PG8_LDB(B0, 0, 0); PG8_LDB(B1, 0, 1); PG8_SCHED; PG8_LDA(At, 0, 0); PG8_STAGE(PG8_SA(1, 1), a1, ac[1]);
            PG8_WAIT_V(8); PG8_WAIT_L(0); PG8_BAR; PG8_MMA(0, 0, At, B0); PG8_MMA(0, 1, At, B1); PG8_BAR; PG8_SCHED;
            PG8_LDA(At, 0, 1); PG8_STAGE(PG8_SB(0, 0), b2, voffB); PG8_STAGE(PG8_SB(0, 1), b2 + hstep, voffB); PG8_STAGE(PG8_SA(0, 0), a2, o2[0]);
            PG8_WAIT_V(8); PG8_WAIT_L(0); PG8_BAR; PG8_MMA(1, 0, At, B0); PG8_MMA(1, 1, At, B1); PG8_BAR; PG8_SCHED;
            PG8_LDB(B0, 1, 0); PG8_LDB(B1, 1, 1); PG8_SCHED; PG8_LDA(At, 1, 0); PG8_STAGE(PG8_SA(0, 1), a2, o2[1]);
            PG8_WAIT_V(8); PG8_WAIT_L(0); PG8_BAR; PG8_MMA(0, 0, At, B0); PG8_MMA(0, 1, At, B1); PG8_BAR; PG8_SCHED;
            PG8_LDA(At, 1, 1); PG8_STAGE(PG8_SB(1, 0), b3, voffB); PG8_STAGE(PG8_SB(1, 1), b3 + hstep, voffB); PG8_STAGE(PG8_SA(1, 0), a3, o2[0]);
            PG8_WAIT_V(8); PG8_WAIT_L(0); PG8_BAR; PG8_MMA(1, 0, At, B0); PG8_MMA(1, 1, At, B1); PG8_BAR; PG8_SCHED;
        }
        if constexpr (ALIGN_EPI) { if (wr == 0) PG8_BAR; }
        E(acc, cur, wr, wc, fr, fq);
        if (!has_next) break;
#pragma unroll
        for (int a = 0; a < 2; ++a)
#pragma unroll
            for (int b = 0; b < 2; ++b)
#pragma unroll
                for (int m = 0; m < 4; ++m)
#pragma unroll
                    for (int n = 0; n < 2; ++n) acc[a][b][m][n] = (f32x4){0.f, 0.f, 0.f, 0.f};
        cur = nxt; cB = nB; ++ui;
#pragma unroll
        for (int h = 0; h < 2; ++h)
#pragma unroll
            for (int i = 0; i < 2; ++i) ac[h][i] = an[h][i];
        if constexpr (ALIGN_EPI) { if (wr == 1) PG8_BAR; }
    }
    PG8_WAIT_V(0);
    if constexpr (!ALIGN_EPI) { if (wr == 0) PG8_BAR; }
    PG8_BAR;
#undef PG8_SA
#undef PG8_SB
#undef PG8_STAGE
#undef PG8_LDA
#undef PG8_LDB
#undef PG8_MMA
#undef PG8_WAIT_V
#undef PG8_WAIT_L
#undef PG8_BAR
#undef PG8_SCHED
#undef PG8_AOFFS
}

struct DenseA { unsigned rowbytes; __device__ __forceinline__ unsigned operator()(const Unit& u, int h, int R) const { return (unsigned)(u.pm * BM + h * HALF + R) * rowbytes; } };

struct StaticOrder {
    int nM, nN, nwg, G, c;
    __device__ __forceinline__ void init(int M, int N, int G_, int c_) { nM = M / BM; nN = N / BM; nwg = nM * nN; G = G_; c = c_; }
    __device__ __forceinline__ bool next(int i, Unit& u) const {
        const long L = (long)i * G + c; if (L >= nwg) return false;
        int wgid = (int)L; { const int q = nwg / 8, r = nwg % 8, xcd = wgid % 8, off = wgid / 8; wgid = (xcd < r ? xcd * (q + 1) : r * (q + 1) + (xcd - r) * q) + off; }
        const int nig = 8 * nN, gid = wgid / nig, fm = gid * 8, gsz = (nM - fm) < 8 ? (nM - fm) : 8;
        u.pm = fm + ((wgid % nig) % gsz); u.pn = (wgid % nig) / gsz; u.e = 0; u.r0 = 0; return true;
    }
    __device__ __forceinline__ void a_ready(const Unit&) const {}
};

struct Args { const float* in[32]; float* out; unsigned char* ws; int ph_lo, ph_hi; };


#define XB_TMO      128
#define XB_XCNT(j)  (256  + 64 * (j))
#define XB_XSUB(j)  (1280 + 64 * (j))
#define XB_XGEN(j)  (2304 + 64 * (j))
#define XB_TOP      3328
#define XB_TOPGEN   3392
#define XCD_BAR_WORDS 3456
#define XB_SPIN_CAP (1u << 18)
__device__ __forceinline__ unsigned xb_ld(unsigned* p)              { return __hip_atomic_load(p, __ATOMIC_RELAXED, __HIP_MEMORY_SCOPE_AGENT); }
__device__ __forceinline__ unsigned xb_add(unsigned* p, unsigned v) { return __hip_atomic_fetch_add(p, v, __ATOMIC_RELAXED, __HIP_MEMORY_SCOPE_AGENT); }
__device__ __forceinline__ unsigned xb_xcc_id() { return (unsigned)__builtin_amdgcn_s_getreg((3 << 11) | 20) & 0xFu; }
#define XB_SPIN(cond, bar) do { unsigned _sp = 0; while (cond) { __builtin_amdgcn_s_sleep(1); \
    if ((++_sp & 255u) == 0u) { if (xb_ld(&(bar)[XB_TMO])) break; if (_sp > XB_SPIN_CAP) { atomicAdd(&(bar)[XB_TMO], 1u); break; } } } } while (0)
struct XcdBarrier { unsigned* bar; unsigned x; volatile LAS unsigned* st; };
__device__ __forceinline__ XcdBarrier xcd_barrier_post(unsigned* bar, volatile LAS unsigned* st) {
    XcdBarrier b; b.bar = bar; b.x = xb_xcc_id(); b.st = st;
    if (threadIdx.x == 0) (void)xb_add(&bar[XB_XCNT(b.x)], 1u);
    return b;
}
__device__ __forceinline__ void xcd_barrier_complete(unsigned* bar, unsigned x, unsigned& nloc, unsigned& nx) {
    const unsigned G = gridDim.x * gridDim.y * gridDim.z;
    unsigned sum, cnt, mine, sp = 0u;
    for (;;) {
        sum = 0u; cnt = 0u; mine = 0u;
#pragma unroll
        for (unsigned j = 0; j < 16; ++j) { const unsigned c = xb_ld(&bar[XB_XCNT(j)]); sum += c; cnt += (c > 0u) ? 1u : 0u; mine = (j == x) ? c : mine; }
        if (sum == G) break;
        __builtin_amdgcn_s_sleep(1);
        if ((++sp & 255u) == 0u) { if (xb_ld(&bar[XB_TMO])) break; if (sp > XB_SPIN_CAP) { atomicAdd(&bar[XB_TMO], 1u); break; } }
    }
    nloc = mine > 0u ? mine : 1u; nx = cnt > 0u ? cnt : 1u;
}
__device__ __forceinline__ void xcd_barrier(const XcdBarrier& b) {
    asm volatile("s_waitcnt vmcnt(0)" ::: "memory");
    __syncthreads();
    if (threadIdx.x == 0) {
        unsigned* bar = b.bar;
        __builtin_amdgcn_s_waitcnt(0);
        unsigned nloc = b.st[0], nx = b.st[1];
        if (nloc == 0u) { xcd_barrier_complete(bar, b.x, nloc, nx); b.st[0] = nloc; b.st[1] = nx; }
        const unsigned old = xb_add(&bar[XB_XSUB(b.x)], 1u);
        const unsigned gen = old / nloc;
        if (old + 1u == (gen + 1u) * nloc) {
            __builtin_amdgcn_fence(__ATOMIC_RELEASE, "agent");
            asm volatile("s_waitcnt vmcnt(0)" ::: "memory");
            const unsigned og = xb_add(&bar[XB_TOP], 1u);
            const unsigned tg = og / nx;
            if (og + 1u == (tg + 1u) * nx) xb_add(&bar[XB_TOPGEN], 1u);
            else XB_SPIN(xb_ld(&bar[XB_TOPGEN]) == tg, bar);
            __builtin_amdgcn_fence(__ATOMIC_ACQUIRE, "agent");
            xb_add(&bar[XB_XGEN(b.x)], 1u);
            asm volatile("s_waitcnt vmcnt(0)" ::: "memory");
        } else {
            XB_SPIN(xb_ld(&bar[XB_XGEN(b.x)]) == gen, bar);
            __builtin_amdgcn_fence(__ATOMIC_ACQUIRE, "agent");
            asm volatile("s_waitcnt vmcnt(0)" ::: "memory");
        }
    }
    __syncthreads();
}

constexpr int TAB_BASE = LDS_BYTES - 4096;
constexpr int XBST_OFF = TAB_BASE + 640;
constexpr int PTAB_OFF = TAB_BASE + 128;
__device__ __forceinline__ unsigned long long ptab_get(LAS unsigned char* lds, int k) {
    const LAS unsigned* p = (const LAS unsigned*)(lds + PTAB_OFF) + 2 * k;
    const unsigned lo = __builtin_amdgcn_readfirstlane(p[0]), hi = __builtin_amdgcn_readfirstlane(p[1]);
    return ((unsigned long long)hi << 32) | lo;
}
#define INP(k) ((const float*)(const GAS float*)ptab_get(F.lds, (k)))
#define P_OUT ((float*)(GAS float*)ptab_get(F.lds, 32))

struct Frame {
    LAS unsigned char* lds;
    int tid, lane, wave, G, bid;
    unsigned char* ws;
};

__device__ __forceinline__ Frame make_frame(unsigned char* lds_raw) {
    Frame F; F.lds = (LAS unsigned char*)lds_raw;
    int tid = threadIdx.x; asm volatile("" : "+v"(tid));
    F.tid = tid; F.lane = tid & 63; F.wave = __builtin_amdgcn_readfirstlane(tid >> 6);
    F.G = gridDim.x; F.bid = blockIdx.x; F.ws = (unsigned char*)(GAS unsigned char*)ptab_get(F.lds, 33);
    return F;
}
constexpr int CONV_SCR = 64 * 65 * 4;
template <class Src>
__device__ __forceinline__ void tile_load(const Src& src, int nblk, int item, int lane, f32x4 (&v)[16]) {
    const int kb = item / nblk, nb = item % nblk, k0 = 64 * kb, n0 = 64 * nb;
    const int q = lane & 15, ks = lane >> 4;
#pragma unroll
    for (int i = 0; i < 16; ++i) { const float* p = src.ptr(k0 + 4 * i + ks, n0, q); v[i] = p ? *(const f32x4*)p : (f32x4){0.f, 0.f, 0.f, 0.f}; }
}
template <class Src>
__device__ __forceinline__ void tile_store(const Src& src, int K, bf16_t* WT, int nblk, LAS float* scr, int item, int lane, const f32x4 (&v)[16]) {
    const int kb = item / nblk, nb = item % nblk, k0 = 64 * kb, n0 = 64 * nb;
    const int q = lane & 15, ks = lane >> 4;
    const int d0 = src.dst(n0, q, 0), d1 = src.dst(n0, q, 1), d2 = src.dst(n0, q, 2), d3 = src.dst(n0, q, 3);
#pragma unroll
    for (int i = 0; i < 16; ++i) { LAS float* r = scr + (4 * i + ks) * 65; r[d0] = v[i][0]; r[d1] = v[i][1]; r[d2] = v[i][2]; r[d3] = v[i][3]; }
    asm volatile("s_waitcnt lgkmcnt(0)" ::: "memory");
    const int c = lane & 7;
#pragma unroll
    for (int j = 0; j < 8; ++j) { const int n = (lane >> 3) + 8 * j; const LAS float* s = scr + (8 * c) * 65 + n;
        u32x4 o; o.x = pk2(s[0 * 65], s[1 * 65]); o.y = pk2(s[2 * 65], s[3 * 65]); o.z = pk2(s[4 * 65], s[5 * 65]); o.w = pk2(s[6 * 65], s[7 * 65]);
        *(u32x4*)(WT + (size_t)(n0 + n) * K + k0 + 8 * c) = o; }
    asm volatile("s_waitcnt lgkmcnt(0)" ::: "memory");
}
template <class Src>
__device__ __forceinline__ void transpose_tile(const Src& src, int K, bf16_t* WT, int nblk, LAS float* scr, int item, int lane) {
    f32x4 v[16]; tile_load(src, nblk, item, lane, v); tile_store(src, K, WT, nblk, scr, item, lane, v);
}
#define CONV_LOOP(SRC_T, first, stride, count, MK) do { \
        int it_ = (first); f32x4 cur_[16], nxt_[16]; \
        if (it_ < (count)) { SRC_T s_; int K_, nblk_, r_; bf16_t* WT_; MK(it_, s_, K_, WT_, nblk_, r_); tile_load(s_, nblk_, r_, F.lane, cur_); } \
        while (it_ < (count)) { const int itn_ = it_ + (stride); \
            if (itn_ < (count)) { SRC_T s_; int K_, nblk_, r_; bf16_t* WT_; MK(itn_, s_, K_, WT_, nblk_, r_); tile_load(s_, nblk_, r_, F.lane, nxt_); } \
            { SRC_T s_; int K_, nblk_, r_; bf16_t* WT_; MK(it_, s_, K_, WT_, nblk_, r_); tile_store(s_, K_, WT_, nblk_, scr, r_, F.lane, cur_); } \
            _Pragma("unroll") for (int i_ = 0; i_ < 16; ++i_) cur_[i_] = nxt_[i_]; \
            it_ = itn_; } } while (0)
struct SrcPlain { const float* w; int N;
    __device__ __forceinline__ const float* ptr(int k, int n0, int q) const { return w + (size_t)k * N + n0 + 4 * q; }
    __device__ __forceinline__ int dst(int, int q, int e) const { return 4 * q + e; } };
struct SrcW1e { const float* wg; const float* wu;
    __device__ __forceinline__ const float* ptr(int k, int n0, int q) const { const float* w = (const float*)((unsigned long long)wg + (unsigned long long)(q >> 3) * ((unsigned long long)wu - (unsigned long long)wg)); return w + (size_t)k * 512 + (n0 >> 1) + 4 * (q & 7); }
    __device__ __forceinline__ int dst(int, int q, int e) const { return 2 * (4 * (q & 7) + e) + (q >> 3); } };

constexpr size_t OUT_W1E = 32 * MiB;
constexpr int W1E_EARLY = 8;
__device__ __forceinline__ void conv_w1e(Frame& F, const float* wgate, const float* wup, bf16_t* W1e, int e_lo, int e_hi, int first, int stride) {
    LAS float* scr = (LAS float*)(F.lds + F.wave * CONV_SCR);
    constexpr int I1 = (1024 / 64) * (1024 / 64);
#define MK_W1E(it, s, K, WT, nblk, r) do { const int e_ = (it) / I1; r = (it) % I1; s = SrcW1e{wgate + (size_t)e_ * 1024 * 512, wup + (size_t)e_ * 1024 * 512}; K = 1024; WT = W1e + (size_t)e_ * 1024 * 1024; nblk = 16; } while (0)
    CONV_LOOP(SrcW1e, e_lo * I1 + first, stride, e_hi * I1, MK_W1E);
#undef MK_W1E
}

__device__ __forceinline__ void route_phase(Frame& F, const bf16_t* x1, const float* g2, const float* rgw, const float* rgb, const float* rew, const float* reb,
                                            const float* wgate, const float* wup, const float* wdown, bf16_t* W1e, unsigned* x1rdy) {
    unsigned char* ws = F.ws;
    {
        LAS float* scr = (LAS float*)(F.lds + F.wave * CONV_SCR);
        const int gw = F.bid * 8 + F.wave, NGW = F.G * 8;
        bf16_t* WdT = (bf16_t*)(ws + WS_WDT);
        constexpr int I2 = (512 / 64) * (1024 / 64);
#define MK_WDT(it, s, K, WT, nblk, r) do { const int e_ = (it) / I2; r = (it) % I2; s = SrcPlain{wdown + (size_t)e_ * 512 * 1024, 1024}; K = 512; WT = WdT + (size_t)e_ * 1024 * 512; nblk = 16; } while (0)
        conv_w1e(F, wgate, wup, W1e, (F.G == 256) ? W1E_EARLY : 0, 16, gw, NGW);
        CONV_LOOP(SrcPlain, gw, NGW, 16 * I2, MK_WDT);
#undef MK_WDT
    }
    __syncthreads();
    constexpr int XT_S = 264;
    LAS bf16_t* XH = (LAS bf16_t*)(F.lds); LAS bf16_t* XL = XH + 64 * XT_S; LAS bf16_t* WH = XL + 64 * XT_S; LAS bf16_t* WL = WH + 32 * XT_S;
    LAS float* LG = (LAS float*)(F.lds + (2 * 64 + 2 * 32) * XT_S * 2);
    LAS unsigned* lcnt = (LAS unsigned*)(F.lds + (2 * 64 + 2 * 32) * XT_S * 2 + 64 * 33 * 4);
    LAS unsigned* lbase = lcnt + 16;
    LAS unsigned* tinfo = lbase + 16;
    unsigned* gcnt = (unsigned*)(ws + WS_GCNT); float* tokw = (float*)(ws + WS_TOKW); unsigned* list = (unsigned*)(ws + WS_LIST);
    bf16_t* H2 = (bf16_t*)(ws + WS_H2);
    const bf16_t* WRS = (const bf16_t*)(ws + WS_WRS);
    const int mt = F.wave & 3, nt = F.wave >> 2, fr = F.lane & 15, fq = F.lane >> 4;
    for (int tile = F.bid; tile < T / 64; tile += F.G) {
        if (x1rdy) {
            if (F.tid < 64) {
                unsigned sp = 0;
                while ((unsigned)__builtin_amdgcn_readfirstlane(__hip_atomic_load(x1rdy + 16 * (tile >> 2), __ATOMIC_RELAXED, __HIP_MEMORY_SCOPE_AGENT)) < 32u) { __builtin_amdgcn_s_sleep(2); if (++sp > (1u << 22)) break; }
                __builtin_amdgcn_fence(__ATOMIC_ACQUIRE, "agent");
            }
            __syncthreads();
        }
        if (F.tid < 16) lcnt[F.tid] = 0u;
        const int tk0 = F.wave * 8, t0 = tile * 64 + tk0;
        u32x2 xr[8][4]; float rinv[8];
#pragma unroll
        for (int u = 0; u < 8; ++u) { const u32x2* xp = (const u32x2*)(x1 + (size_t)(t0 + u) * D) + F.lane;
#pragma unroll
            for (int j = 0; j < 4; ++j) xr[u][j] = xp[64 * j]; }
#pragma unroll
        for (int u = 0; u < 8; ++u) { float ss = 0.f;
#pragma unroll
            for (int j = 0; j < 4; ++j) { const float a = __builtin_bit_cast(float, xr[u][j].x << 16), b = __builtin_bit_cast(float, xr[u][j].x & 0xffff0000u), c = __builtin_bit_cast(float, xr[u][j].y << 16), d = __builtin_bit_cast(float, xr[u][j].y & 0xffff0000u);
                ss += (a * a + b * b) + (c * c + d * d); }
            rinv[u] = rsqrtf(wave_sum_dpp(ss) * (1.f / D) + 1e-6f); }
        f32x4 acc = (f32x4){0.f, 0.f, 0.f, 0.f};
#pragma unroll 1
        for (int j = 0; j < 4; ++j) {
            u32x4 wq[4];
#pragma unroll
            for (int i = 0; i < 4; ++i) { const int pc = F.tid + 512 * i, hl = pc >> 10, n = (pc >> 5) & 31, c8 = pc & 31; wq[i] = *(const u32x4*)(WRS + (size_t)hl * 32 * 1024 + (size_t)n * 1024 + 256 * j + 8 * c8); }
            const f32x4 gv = ((const f32x4*)g2)[F.lane + 64 * j];
#pragma unroll
            for (int u = 0; u < 8; ++u) { const u32x2 xb = (j == 0) ? xr[u][0] : (j == 1) ? xr[u][1] : (j == 2) ? xr[u][2] : xr[u][3];
                f32x4 h; h.x = __builtin_bit_cast(float, xb.x << 16); h.y = __builtin_bit_cast(float, xb.x & 0xffff0000u); h.z = __builtin_bit_cast(float, xb.y << 16); h.w = __builtin_bit_cast(float, xb.y & 0xffff0000u);
                h = h * rinv[u] * gv;
                const unsigned p0 = pk2(h.x, h.y), p1 = pk2(h.z, h.w);
                ((unsigned long long*)(H2 + (size_t)(t0 + u) * D) + F.lane)[64 * j] = (unsigned long long)p0 | ((unsigned long long)p1 << 32);
                const unsigned q0 = pk2(h.x - __builtin_bit_cast(float, p0 << 16), h.y - __builtin_bit_cast(float, p0 & 0xffff0000u)), q1 = pk2(h.z - __builtin_bit_cast(float, p1 << 16), h.w - __builtin_bit_cast(float, p1 & 0xffff0000u));
                *(LAS u32x2*)(XH + (tk0 + u) * XT_S + 4 * F.lane) = (u32x2){p0, p1}; *(LAS u32x2*)(XL + (tk0 + u) * XT_S + 4 * F.lane) = (u32x2){q0, q1}; }
#pragma unroll
            for (int i = 0; i < 4; ++i) { const int pc = F.tid + 512 * i, hl = pc >> 10, n = (pc >> 5) & 31, c8 = pc & 31; *(LAS u32x4*)((hl ? WL : WH) + n * XT_S + 8 * c8) = wq[i]; }
            __syncthreads();
#pragma unroll
            for (int ks = 0; ks < 8; ++ks) {
                const bf16x8 bhk = *(const LAS bf16x8*)(WH + (16 * nt + fr) * XT_S + 32 * ks + 8 * fq), blk = *(const LAS bf16x8*)(WL + (16 * nt + fr) * XT_S + 32 * ks + 8 * fq);
                const bf16x8 ah = *(const LAS bf16x8*)(XH + (16 * mt + fr) * XT_S + 32 * ks + 8 * fq), al = *(const LAS bf16x8*)(XL + (16 * mt + fr) * XT_S + 32 * ks + 8 * fq);
                acc = __builtin_amdgcn_mfma_f32_16x16x32_bf16(ah, bhk, acc, 0, 0, 0); acc = __builtin_amdgcn_mfma_f32_16x16x32_bf16(ah, blk, acc, 0, 0, 0); acc = __builtin_amdgcn_mfma_f32_16x16x32_bf16(al, bhk, acc, 0, 0, 0);
            }
            __syncthreads();
        }
#pragma unroll
        for (int r = 0; r < 4; ++r) LG[(16 * mt + 4 * fq + r) * 33 + 16 * nt + fr] = acc[r];
        __syncthreads();
        if (F.tid < 64) {
            const int tk = F.tid, t = tile * 64 + tk; float lg[20];
#pragma unroll
            for (int q = 0; q < 20; ++q) lg[q] = LG[tk * 33 + q];
            const float gl0 = lg[0] + rgb[0], gl1 = lg[1] + rgb[1], gl2 = lg[2] + rgb[2], gl3 = lg[3] + rgb[3];
            int gi = 0; float gb = gl0;
            if (gl1 > gb) { gb = gl1; gi = 1; } if (gl2 > gb) { gb = gl2; gi = 2; } if (gl3 > gb) { gb = gl3; gi = 3; }
            const float gs = expf(gl0 - gb) + expf(gl1 - gb) + expf(gl2 - gb) + expf(gl3 - gb);
            const float gwt = 1.0f / gs;
            float e0 = gi == 0 ? lg[4] : gi == 1 ? lg[8] : gi == 2 ? lg[12] : lg[16];
            float e1 = gi == 0 ? lg[5] : gi == 1 ? lg[9] : gi == 2 ? lg[13] : lg[17];
            float e2 = gi == 0 ? lg[6] : gi == 1 ? lg[10] : gi == 2 ? lg[14] : lg[18];
            float e3 = gi == 0 ? lg[7] : gi == 1 ? lg[11] : gi == 2 ? lg[15] : lg[19];
            e0 += reb[gi * 4 + 0]; e1 += reb[gi * 4 + 1]; e2 += reb[gi * 4 + 2]; e3 += reb[gi * 4 + 3];
            const float em = fmaxf(fmaxf(e0, e1), fmaxf(e2, e3));
            const float p0 = expf(e0 - em), p1 = expf(e1 - em), p2 = expf(e2 - em), p3 = expf(e3 - em);
            int i0 = 0; float b0 = p0;
            if (p1 > b0) { b0 = p1; i0 = 1; } if (p2 > b0) { b0 = p2; i0 = 2; } if (p3 > b0) { b0 = p3; i0 = 3; }
            int i1 = -1; float b1 = -1.f;
            if (i0 != 0 && p0 > b1) { b1 = p0; i1 = 0; } if (i0 != 1 && p1 > b1) { b1 = p1; i1 = 1; } if (i0 != 2 && p2 > b1) { b1 = p2; i1 = 2; } if (i0 != 3 && p3 > b1) { b1 = p3; i1 = 3; }
            const float den = b0 + b1;
            const int ea = gi * 4 + i0, eb = gi * 4 + i1;
            const unsigned ra = atomicAdd((unsigned*)&lcnt[ea], 1u), rb = atomicAdd((unsigned*)&lcnt[eb], 1u);
            tinfo[tk * 2 + 0] = (unsigned)ea | (ra << 4); tinfo[tk * 2 + 1] = (unsigned)eb | (rb << 4);
            tokw[(size_t)t * 2 + 0] = gwt * (b0 / den); tokw[(size_t)t * 2 + 1] = gwt * (b1 / den);
        }
        __syncthreads();
        if (F.tid < 16) lbase[F.tid] = atomicAdd(&gcnt[F.tid], lcnt[F.tid]);
        __syncthreads();
        if (F.tid < 128) { const unsigned info = tinfo[F.tid]; const unsigned e = info & 15u, r = info >> 4; list[(size_t)e * T + lbase[e] + r] = (unsigned)((tile * 64 + (F.tid >> 1)) * 2 + (F.tid & 1)); }
        __syncthreads();
    }
}
#ifndef MOE_DBL
#define MOE_DBL 0
#endif
struct MoeSched {
    const LAS int* pre;
    int G, c, npn;
    int second;
    unsigned* ready;
    __device__ __forceinline__ void a_ready(const Unit& u) const {
        if (ready == nullptr) return;
        if (threadIdx.x < 64) {
            unsigned sp = 0;
            while ((unsigned)__builtin_amdgcn_readfirstlane(__hip_atomic_load(ready + 16 * u.pm, __ATOMIC_RELAXED, __HIP_MEMORY_SCOPE_AGENT)) < (32u << MOE_DBL)) { __builtin_amdgcn_s_sleep(2); if (++sp > (1u << 22)) break; }
            __builtin_amdgcn_fence(__ATOMIC_ACQUIRE, "agent");
            asm volatile("s_waitcnt vmcnt(0)" ::: "memory");
        }
        asm volatile("" ::: "memory"); __builtin_amdgcn_s_barrier(); asm volatile("" ::: "memory");
    }
    __device__ __forceinline__ bool next(int i_, Unit& u) const {
        const int i = i_ >> MOE_DBL;
        int e, rt, pl, L;
        const int nun = pre[16] * npn;
        if (G == 256) {
            const int v = (c & 7) * 32 + (c >> 3);
            const int r1 = nun & 255, nl = 256 - r1;
            if (!second) L = i * 256 + v;
            else if (v >= r1) L = (i == 0) ? (v - r1) : (i == 1) ? nl + (v - r1) : 2 * nl + (i - 2) * 256 + v;
            else L = 2 * nl + i * 256 + v;
        } else L = i * G + c;
        if (L >= nun) return false;
        rt = L / npn; pl = L % npn; e = 0;
#pragma unroll
        for (int q = 1; q < 16; ++q) e += (rt >= pre[q]) ? 1 : 0;
        u.pm = __builtin_amdgcn_readfirstlane(rt); u.pn = __builtin_amdgcn_readfirstlane(e * npn + pl); u.e = __builtin_amdgcn_readfirstlane(e); u.r0 = __builtin_amdgcn_readfirstlane((rt - pre[e]) * BM); return true;
    }
};
struct GatherA {
    static constexpr bool DENSE = false;
    __device__ __forceinline__ size_t ubase(const Unit&) const { return 0; }
    const unsigned* list; const unsigned* gcnt;
    __device__ __forceinline__ unsigned operator()(const Unit& u, int h, int R) const {
        const int rank = u.r0 + h * HALF + R; const unsigned cnt = gcnt[u.e];
        const unsigned ent = ((unsigned)rank < cnt) ? list[(size_t)u.e * T + rank] : 0u;
        return (ent >> 1) * (unsigned)(D * 2);
    }
};
__device__ __forceinline__ float silu_f(float x) { return x * __builtin_amdgcn_rcpf(1.0f + __builtin_amdgcn_exp2f(-1.4426950408889634f * x)); }
struct EpiMoe1 {
    static constexpr bool PERM = true;
    bf16_t* ACT; unsigned* ready;
    __device__ __forceinline__ void operator()(const f32x4 (&acc)[2][2][4][2], const Unit& u, int wr, int wc, int fr, int fq) const {
        const int row0 = u.pm * BM + wr * 64 + fr; const int ch0 = (u.pn & 3) * 128 + wc * 16 + 4 * fq;
#pragma unroll
        for (int ai = 0; ai < 2; ++ai)
#pragma unroll
            for (int m = 0; m < 4; ++m) { bf16_t* rowp = ACT + (size_t)(row0 + ai * HALF + m * 16) * 512 + ch0;
#pragma unroll
                for (int bj = 0; bj < 2; ++bj) { const f32x4 v0 = acc[ai][bj][m][0], v1 = acc[ai][bj][m][1];
                    u32x2 w; w.x = pk2(silu_f(v0[0]) * v0[1], silu_f(v0[2]) * v0[3]); w.y = pk2(silu_f(v1[0]) * v1[1], silu_f(v1[2]) * v1[3]);
                    __hip_atomic_store((unsigned long long*)(rowp + bj * 64), (unsigned long long)w.x | ((unsigned long long)w.y << 32), __ATOMIC_RELAXED, __HIP_MEMORY_SCOPE_AGENT); } }
        asm volatile("s_waitcnt vmcnt(0)" ::: "memory");
        if ((threadIdx.x & 63) == 0) __hip_atomic_fetch_add(ready + 16 * u.pm, 1u, __ATOMIC_RELAXED, __HIP_MEMORY_SCOPE_AGENT);
    }
};
typedef DenseA DenseAct;
struct EpiMoe2 {
    static constexpr bool PERM = true;
    bf16_t* Y0; bf16_t* Y1; const unsigned* list; const unsigned* gcnt; const float* tokw;
    __device__ __forceinline__ void operator()(const f32x4 (&acc)[2][2][4][2], const Unit& u, int wr, int wc, int fr, int fq) const {
        const unsigned cnt = gcnt[u.e]; const int col0 = (u.pn & 3) * BM + wc * 32 + 8 * fq;
        unsigned ent[8]; float w[8];
#pragma unroll
        for (int i = 0; i < 8; ++i) { const int rank = u.r0 + (i >> 2) * HALF + wr * 64 + (i & 3) * 16 + fr; ent[i] = ((unsigned)rank < cnt) ? list[(size_t)u.e * T + rank] : 0xffffffffu; }
#pragma unroll
        for (int i = 0; i < 8; ++i) w[i] = (ent[i] != 0xffffffffu) ? tokw[ent[i]] : 0.f;
#pragma unroll
        for (int ai = 0; ai < 2; ++ai)
#pragma unroll
            for (int m = 0; m < 4; ++m) {
                const unsigned en = ent[ai * 4 + m]; const float wv = w[ai * 4 + m];
                if (en != 0xffffffffu) {
                    bf16_t* rowp = (bf16_t*)((unsigned long long)Y0 + (unsigned long long)(en & 1u) * ((unsigned long long)Y1 - (unsigned long long)Y0)) + (size_t)(en >> 1) * D + col0;
#pragma unroll
                    for (int bj = 0; bj < 2; ++bj) { const f32x4 v0 = acc[ai][bj][m][0] * wv, v1 = acc[ai][bj][m][1] * wv;
                        u32x4 o; o.x = pk2(v0[0], v0[1]); o.y = pk2(v0[2], v0[3]); o.z = pk2(v1[0], v1[1]); o.w = pk2(v1[2], v1[3]);
                        *(u32x4*)(rowp + bj * HALF) = o; }
                }
            }
    }
};
__device__ __forceinline__ void moe_prefix(Frame& F, LAS int* pre) {
    if (F.tid == 0) { const unsigned* gcnt = (const unsigned*)(F.ws + WS_GCNT); int s = 0; for (int e = 0; e < 16; ++e) { pre[e] = s; s += (int)((gcnt[e] + 255u) >> 8); } pre[16] = s; }
    __syncthreads();
}

__device__ __forceinline__ void final_phase(Frame& F, const bf16_t* xi, float* xo, const float* gf) {
    const bf16_t* Y0 = (const bf16_t*)(F.ws + WS_Y0); const bf16_t* Y1 = (const bf16_t*)(F.ws + WS_Y1);
    const int gw = F.bid * 8 + F.wave, NGW = F.G * 8;
    f32x4 gv4[4];
#pragma unroll
    for (int j = 0; j < 4; ++j) gv4[j] = ((const f32x4*)gf)[F.lane + 64 * j];
#pragma unroll 1
    for (int t = gw; t < T; t += 4 * NGW) {
        u32x2 xb[4][4], ya[4][4], yb[4][4];
#pragma unroll
        for (int u = 0; u < 4; ++u) { const int tr = (t + u * NGW < T) ? t + u * NGW : t;
            const u32x2* xr = (const u32x2*)(xi + (size_t)tr * D) + F.lane; const u32x2* y0 = (const u32x2*)(Y0 + (size_t)tr * D) + F.lane; const u32x2* y1 = (const u32x2*)(Y1 + (size_t)tr * D) + F.lane;
#pragma unroll
            for (int j = 0; j < 4; ++j) { xb[u][j] = xr[64 * j]; ya[u][j] = y0[64 * j]; yb[u][j] = y1[64 * j]; } }
#pragma unroll
        for (int u = 0; u < 4; ++u) { const int tr = t + u * NGW; f32x4 v[4]; float ss = 0.f;
#pragma unroll
            for (int j = 0; j < 4; ++j) { const u32x2 x2 = xb[u][j], a = ya[u][j], b = yb[u][j];
                v[j].x = __builtin_bit_cast(float, x2.x << 16) + (__builtin_bit_cast(float, a.x << 16) + __builtin_bit_cast(float, b.x << 16));
                v[j].y = __builtin_bit_cast(float, x2.x & 0xffff0000u) + (__builtin_bit_cast(float, a.x & 0xffff0000u) + __builtin_bit_cast(float, b.x & 0xffff0000u));
                v[j].z = __builtin_bit_cast(float, x2.y << 16) + (__builtin_bit_cast(float, a.y << 16) + __builtin_bit_cast(float, b.y << 16));
                v[j].w = __builtin_bit_cast(float, x2.y & 0xffff0000u) + (__builtin_bit_cast(float, a.y & 0xffff0000u) + __builtin_bit_cast(float, b.y & 0xffff0000u));
                ss += (v[j].x * v[j].x + v[j].y * v[j].y) + (v[j].z * v[j].z + v[j].w * v[j].w); }
            const float rinv = rsqrtf(wave_sum(ss) * (1.f / D) + 1e-6f);
            if (tr < T) { f32x4* xw = (f32x4*)(xo + (size_t)tr * D) + F.lane;
#pragma unroll
                for (int j = 0; j < 4; ++j) xw[64 * j] = v[j] * rinv * gv4[j]; }
        }
    }
}

struct AttnPtrs { const bf16_t *Q, *KS, *VS, *KW, *VW, *KC, *VC; const float* NG; bf16_t* O; int nb; unsigned* ready; unsigned* ordy; };
typedef short v4i16_t __attribute__((ext_vector_type(4)));
constexpr int AT_K = 0  , AT_V = 32768  , AT_PSUM = 81920, AT_SCR = AT_PSUM + 4 * 64 * 33 * 4  , AT_OACC = AT_PSUM  ,
              AT_WSF = AT_OACC + 65536, AT_SELM = AT_WSF + 8 * 64 * 4, AT_END = AT_SELM + 256;
static_assert(AT_SCR + 64 * 32 * 4 <= AT_WSF, "attention LDS map");
static_assert(AT_END <= LDS_BYTES - 4096, "attention LDS map");
constexpr float MASKV = -1.0e30f;

__device__ __forceinline__ void swap32(float& a, float& b) { asm volatile("s_nop 1\n\tv_permlane32_swap_b32_e32 %0, %1" : "+v"(a), "+v"(b)); }
__device__ __forceinline__ float xhalf_max(float v) { float a = v, b = v; swap32(a, b); return fmaxf(a, b); }
__device__ __forceinline__ float xhalf_sum(float v) { float a = v, b = v; swap32(a, b); return a + b; }
template <int XM> __device__ __forceinline__ unsigned swz_xor(unsigned v) { return (unsigned)__builtin_amdgcn_ds_swizzle((int)v, (XM << 10) | 0x1f); }
__device__ __forceinline__ int crow(int r, int hi) { return (r & 3) + 8 * (r >> 2) + 4 * hi; }
__device__ __forceinline__ float mask_neg(float p, int x) { return fmaf((float)(x >> 31), 1.0e30f, p); }
__device__ __forceinline__ int k_src_chunk(int key, int slot) { return slot ^ ((key >> 1) & 7); }
__device__ __forceinline__ int v_src_chunk(int key, int slot) { return slot ^ (((key >> 1) & 1) << 2); }
__device__ __forceinline__ void kv_load(const bf16_t* Kp, const bf16_t* Vp, long row0, int g, int tid, u32x4& kr, u32x4& vr) {
    const int key = tid >> 3, slot = tid & 7;
    kr = *(const u32x4*)(Kp + (row0 + key) * 256 + g * 64 + k_src_chunk(key, slot) * 8);
    vr = *(const u32x4*)(Vp + (row0 + key) * 256 + g * 64 + v_src_chunk(key, slot) * 8);
}
__device__ __forceinline__ void kv_store(LAS unsigned char* lds, int buf, int tid, const u32x4& kr, const u32x4& vr) {
    *(LAS u32x4*)(lds + AT_K + buf * 8192 + tid * 16) = kr; *(LAS u32x4*)(lds + AT_V + buf * 8192 + tid * 16) = vr;
}
__device__ __forceinline__ int k_frag_off(int key, int chunk) { return key * 128 + ((chunk ^ ((key >> 1) & 7)) << 4); }
__device__ __forceinline__ void qk_tile(const LAS unsigned char* Kb, const bf16x8 (&qr)[4], int r32, int hi, f32x16& p0, f32x16& p1) {
#pragma unroll
    for (int r = 0; r < 16; ++r) { p0[r] = 0.f; p1[r] = 0.f; }
#pragma unroll
    for (int d0 = 0; d0 < 4; ++d0) {
        const bf16x8 a0 = *(const LAS bf16x8*)(Kb + k_frag_off(r32, 2 * d0 + hi));
        const bf16x8 a1 = *(const LAS bf16x8*)(Kb + k_frag_off(r32, 2 * d0 + hi) + 4096);
        p0 = __builtin_amdgcn_mfma_f32_32x32x16_bf16(a0, qr[d0], p0, 0, 0, 0);
        p1 = __builtin_amdgcn_mfma_f32_32x32x16_bf16(a1, qr[d0], p1, 0, 0, 0);
    }
}
__device__ __forceinline__ bf16x8 pack8(const f32x16& p, int base) {
    u32x4 w; w.x = pk2(p[base + 0], p[base + 1]); w.y = pk2(p[base + 2], p[base + 3]); w.z = pk2(p[base + 4], p[base + 5]); w.w = pk2(p[base + 6], p[base + 7]);
    return __builtin_bit_cast(bf16x8, w);
}
template <bool LSUM>
__device__ __forceinline__ void pv_tile_l(const LAS unsigned char* Vb, int lane, const f32x16& p0, const f32x16& p1, f32x16 (&o)[2], f32x16& lacc, const bf16x8& ones) {
    const int hi = lane >> 5;
    const int qp = (lane & 15) >> 2, sw = (qp >> 1) & 1;
    const LAS unsigned char* vp = Vb + (4 * hi + qp) * 128 + ((lane >> 4) & 1) * 32 + (lane & 3) * 8;
    const bf16x8 pa0 = pack8(p0, 0), pa1 = pack8(p0, 8), pa2 = pack8(p1, 0), pa3 = pack8(p1, 8);
    if (LSUM) {
        lacc = __builtin_amdgcn_mfma_f32_32x32x16_bf16(pa0, ones, lacc, 0, 0, 0); lacc = __builtin_amdgcn_mfma_f32_32x32x16_bf16(pa1, ones, lacc, 0, 0, 0);
        lacc = __builtin_amdgcn_mfma_f32_32x32x16_bf16(pa2, ones, lacc, 0, 0, 0); lacc = __builtin_amdgcn_mfma_f32_32x32x16_bf16(pa3, ones, lacc, 0, 0, 0);
    }
#pragma unroll
    for (int d0 = 0; d0 < 2; ++d0) {
#pragma unroll
        for (int ks = 0; ks < 4; ++ks) {
            const v4i16_t lo = __builtin_amdgcn_ds_read_tr16_b64_v4i16((LAS v4i16_t*)(vp + ((d0 ^ sw) << 6) + ks * 2048));
            const v4i16_t hh = __builtin_amdgcn_ds_read_tr16_b64_v4i16((LAS v4i16_t*)(vp + ((d0 ^ sw) << 6) + ks * 2048 + 1024));
            const bf16x8 vf = (bf16x8){lo[0], lo[1], lo[2], lo[3], hh[0], hh[1], hh[2], hh[3]};
            const bf16x8 pa = ks == 0 ? pa0 : ks == 1 ? pa1 : ks == 2 ? pa2 : pa3;
            o[d0] = __builtin_amdgcn_mfma_f32_32x32x16_bf16(pa, vf, o[d0], 0, 0, 0);
        }
    }
}
__device__ __forceinline__ void pv_tile(const LAS unsigned char* Vb, int lane, const f32x16& p0, const f32x16& p1, f32x16 (&o)[2]) {
    const int hi = lane >> 5;
    const int qp = (lane & 15) >> 2, sw = (qp >> 1) & 1;
    const LAS unsigned char* vp = Vb + (4 * hi + qp) * 128 + ((lane >> 4) & 1) * 32 + (lane & 3) * 8;
    const bf16x8 pa0 = pack8(p0, 0), pa1 = pack8(p0, 8), pa2 = pack8(p1, 0), pa3 = pack8(p1, 8);
#pragma unroll
    for (int d0 = 0; d0 < 2; ++d0) {
#pragma unroll
        for (int ks = 0; ks < 4; ++ks) {
            const v4i16_t lo = __builtin_amdgcn_ds_read_tr16_b64_v4i16((LAS v4i16_t*)(vp + ((d0 ^ sw) << 6) + ks * 2048));
            const v4i16_t hh = __builtin_amdgcn_ds_read_tr16_b64_v4i16((LAS v4i16_t*)(vp + ((d0 ^ sw) << 6) + ks * 2048 + 1024));
            const bf16x8 vf = (bf16x8){lo[0], lo[1], lo[2], lo[3], hh[0], hh[1], hh[2], hh[3]};
            const bf16x8 pa = ks == 0 ? pa0 : ks == 1 ? pa1 : ks == 2 ? pa2 : pa3;
            o[d0] = __builtin_amdgcn_mfma_f32_32x32x16_bf16(pa, vf, o[d0], 0, 0, 0);
        }
    }
}
constexpr float RESC_THR = 8.0f;
__device__ __forceinline__ void softmax_step(f32x16& p0, f32x16& p1, float& m_run, float& l_run, f32x16 (&o)[2], LAS float* wsf, int lane) {
    const int q = lane & 31, hi = lane >> 5;
    float mt = p0[0];
#pragma unroll
    for (int r = 1; r < 16; ++r) mt = fmaxf(mt, p0[r]);
#pragma unroll
    for (int r = 0; r < 16; ++r) mt = fmaxf(mt, p1[r]);
    mt = xhalf_max(mt);
    if (__any(mt > m_run + RESC_THR)) {
        const float mn = fmaxf(m_run, mt);
        const float alpha = __builtin_amdgcn_exp2f(m_run - mn);
        m_run = mn; l_run *= alpha;
        if (hi == 0) wsf[q] = alpha;
        asm volatile("s_waitcnt lgkmcnt(0)" ::: "memory");
#pragma unroll
        for (int r4 = 0; r4 < 4; ++r4) { const f32x4 a4 = *(const LAS f32x4*)(wsf + 8 * r4 + 4 * hi);
#pragma unroll
            for (int j = 0; j < 4; ++j) { o[0][4 * r4 + j] *= a4[j]; o[1][4 * r4 + j] *= a4[j]; } }
        asm volatile("" ::: "memory");
    }
    float sum = 0.f;
#pragma unroll
    for (int r = 0; r < 16; ++r) { p0[r] = __builtin_amdgcn_exp2f(p0[r] - m_run); sum += p0[r]; }
#pragma unroll
    for (int r = 0; r < 16; ++r) { p1[r] = __builtin_amdgcn_exp2f(p1[r] - m_run); sum += p1[r]; }
    l_run += sum;
}
__device__ __forceinline__ void glds16(const void* gsrc, unsigned lds_dst) { unsigned keep;
    asm volatile("s_mov_b32 %0, m0\n\ts_mov_b32 m0, %2\n\ts_nop 0\n\tglobal_load_lds_dwordx4 %1, off\n\ts_mov_b32 m0, %0" : "=&s"(keep) : "v"(gsrc), "s"(lds_dst) : "memory"); }
__device__ __forceinline__ void kv_dma(LAS unsigned char* lds, int slot, int vslot, const bf16_t* Kp, const bf16_t* Vp, long row0, int g, int tid) {
    const int wid = __builtin_amdgcn_readfirstlane(tid >> 6), lane = tid & 63;
    const int key = 8 * wid + (lane >> 3), sl16 = lane & 7;
    const bf16_t* ksrc = Kp + (row0 + key) * 256 + g * 64 + k_src_chunk(key, sl16) * 8;
    const bf16_t* vsrc = Vp + (row0 + key) * 256 + g * 64 + v_src_chunk(key, sl16) * 8;
    const unsigned l0 = (unsigned)(size_t)lds;
    glds16(ksrc, (unsigned)__builtin_amdgcn_readfirstlane(l0 + AT_K + slot * 8192 + wid * 1024));
    glds16(vsrc, (unsigned)__builtin_amdgcn_readfirstlane(l0 + AT_V + vslot * 8192 + wid * 1024));
}
__device__ __forceinline__ void qk_tile_c(const LAS unsigned char* Kb, const bf16x8 (&qr)[4], int r32, int hi, const f32x16& ci, f32x16& p0, f32x16& p1) {
#pragma unroll
    for (int d0 = 0; d0 < 4; ++d0) {
        const bf16x8 a0 = *(const LAS bf16x8*)(Kb + k_frag_off(r32, 2 * d0 + hi));
        const bf16x8 a1 = *(const LAS bf16x8*)(Kb + k_frag_off(r32, 2 * d0 + hi) + 4096);
        if (d0 == 0) { p0 = __builtin_amdgcn_mfma_f32_32x32x16_bf16(a0, qr[0], ci, 0, 0, 0); p1 = __builtin_amdgcn_mfma_f32_32x32x16_bf16(a1, qr[0], ci, 0, 0, 0); }
        else { p0 = __builtin_amdgcn_mfma_f32_32x32x16_bf16(a0, qr[d0], p0, 0, 0, 0); p1 = __builtin_amdgcn_mfma_f32_32x32x16_bf16(a1, qr[d0], p1, 0, 0, 0); }
    }
}
__device__ __forceinline__ float softmax_rel(f32x16& p0, f32x16& p1, bool first, float& m_run, float& l_run, f32x16 (&o)[2], LAS float* wsf, int lane, bool& shifted) {
    const int q = lane & 31, hi = lane >> 5;
    float mt = p0[0];
#pragma unroll
    for (int r = 1; r < 16; ++r) mt = fmaxf(mt, p0[r]);
#pragma unroll
    for (int r = 0; r < 16; ++r) mt = fmaxf(mt, p1[r]);
    mt = xhalf_max(mt);
    float delta = 0.f;
    shifted = first || __any(mt > RESC_THR);
    if (shifted) {
        delta = first ? ((mt > -1.0e29f) ? mt : 0.f) : fmaxf(mt, 0.f);
        m_run += delta;
#pragma unroll
        for (int r = 0; r < 16; ++r) { p0[r] -= delta; p1[r] -= delta; }
        if (!first) {
            const float alpha = __builtin_amdgcn_exp2f(-delta);
            l_run *= alpha;
            if (hi == 0) wsf[q] = alpha;
            asm volatile("s_waitcnt lgkmcnt(0)" ::: "memory");
#pragma unroll
            for (int r4 = 0; r4 < 4; ++r4) { const f32x4 a4 = *(const LAS f32x4*)(wsf + 8 * r4 + 4 * hi);
#pragma unroll
                for (int j = 0; j < 4; ++j) { o[0][4 * r4 + j] *= a4[j]; o[1][4 * r4 + j] *= a4[j]; } }
            asm volatile("" ::: "memory");
        }
    }
    float sum = 0.f;
#pragma unroll
    for (int r = 0; r < 16; ++r) { p0[r] = __builtin_amdgcn_exp2f(p0[r]); sum += p0[r]; }
#pragma unroll
    for (int r = 0; r < 16; ++r) { p1[r] = __builtin_amdgcn_exp2f(p1[r]); sum += p1[r]; }
    l_run += sum;
    return delta;
}
__device__ __forceinline__ float max3f(float a, float b, float c) { float d; asm volatile("v_max3_f32 %0, %1, %2, %3" : "=v"(d) : "v"(a), "v"(b), "v"(c)); return d; }
__device__ __forceinline__ void softmax_rel2(f32x16& p0, f32x16& p1, f32x16& p2, f32x16& p3, bool first, float& m_run, f32x16& cm, f32x16& lacc, f32x16 (&o)[2], LAS float* wsf, int lane) {
    const int q = lane & 31, hi = lane >> 5;
    asm volatile("s_nop 15" : "+v"(p0), "+v"(p1), "+v"(p2), "+v"(p3));
    float a = max3f(p0[0], p0[1], p0[2]), b = max3f(p1[0], p1[1], p1[2]), c = max3f(p2[0], p2[1], p2[2]), d = max3f(p3[0], p3[1], p3[2]);
#pragma unroll
    for (int r = 3; r < 15; r += 2) { a = max3f(a, p0[r], p0[r + 1]); b = max3f(b, p1[r], p1[r + 1]); c = max3f(c, p2[r], p2[r + 1]); d = max3f(d, p3[r], p3[r + 1]); }
    a = max3f(a, p0[15], p1[15]); c = max3f(c, p2[15], p3[15]);
    float mt = max3f(a, b, c); mt = max3f(mt, d, d);
    mt = xhalf_max(mt);
    if (first || __any(mt > RESC_THR)) {
        const float delta = first ? ((mt > -1.0e29f) ? mt : 0.f) : fmaxf(mt, 0.f);
        m_run += delta;
#pragma unroll
        for (int r = 0; r < 16; ++r) { p0[r] -= delta; p1[r] -= delta; p2[r] -= delta; p3[r] -= delta; cm[r] = -m_run; }
        if (!first) {
            const float alpha = __builtin_amdgcn_exp2f(-delta);
            if (hi == 0) wsf[q] = alpha;
            asm volatile("s_waitcnt lgkmcnt(0)" ::: "memory");
#pragma unroll
            for (int r4 = 0; r4 < 4; ++r4) { const f32x4 a4 = *(const LAS f32x4*)(wsf + 8 * r4 + 4 * hi);
#pragma unroll
                for (int j = 0; j < 4; ++j) { o[0][4 * r4 + j] *= a4[j]; o[1][4 * r4 + j] *= a4[j]; lacc[4 * r4 + j] *= a4[j]; } }
            asm volatile("" ::: "memory");
        }
    }
#pragma unroll
    for (int r = 0; r < 16; ++r) { p0[r] = __builtin_amdgcn_exp2f(p0[r]); p1[r] = __builtin_amdgcn_exp2f(p1[r]); p2[r] = __builtin_amdgcn_exp2f(p2[r]); p3[r] = __builtin_amdgcn_exp2f(p3[r]); }
}
__device__ __forceinline__ int stage_next(int cs) { const int ks = cs & 1, vs = cs >> 1; return (ks ^ 1) + 2 * (vs == 2 ? 0 : vs + 1); }
template <class CinitF, class PostF, class TailF>
__device__ __forceinline__ int attn_stream(LAS unsigned char* lds, const bf16_t* Kp, const bf16_t* Vp, long row0, int g, int nt, int tid, int lane, const bf16x8 (&qr)[4], LAS float* wsf,
                                           f32x16 (&o)[2], float& m_run, f32x16& lacc, const CinitF& cinit, const PostF& post, int cs, bool late, const TailF& tail) {
    const int q = lane & 31, hi = lane >> 5;
    const int np = (nt + 1) >> 1;
    f32x16 cm;
#pragma unroll
    for (int r = 0; r < 16; ++r) { cm[r] = 0.f; lacc[r] = 0.f; }
    bf16x8 ones = (bf16x8){(short)0x3F80, (short)0x3F80, (short)0x3F80, (short)0x3F80, (short)0x3F80, (short)0x3F80, (short)0x3F80, (short)0x3F80}; asm volatile("" : "+v"(ones));
    for (int p = 0; p < np; ++p) {
        const int t0 = 2 * p; const bool two = t0 + 1 < nt;
        const int kst = (cs & 1) * 2, vst = (cs >> 1) * 2, cn = stage_next(cs);
        if (p + 1 < np) { kv_dma(lds, (cn & 1) * 2, (cn >> 1) * 2, Kp, Vp, row0 + 64 * (t0 + 2), g, tid); if (t0 + 3 < nt) kv_dma(lds, (cn & 1) * 2 + 1, (cn >> 1) * 2 + 1, Kp, Vp, row0 + 64 * (t0 + 3), g, tid); }
        else tail(cn);
        f32x16 s0_, s1, s2, s3;
        { const f32x16 ci = cinit(t0, cm); qk_tile_c(lds + AT_K + kst * 8192, qr, q, hi, ci, s0_, s1); post(t0, s0_, s1); }
        if (two) { const f32x16 ci = cinit(t0 + 1, cm); qk_tile_c(lds + AT_K + (kst + 1) * 8192, qr, q, hi, ci, s2, s3); post(t0 + 1, s2, s3); }
        else {
#pragma unroll
            for (int r = 0; r < 16; ++r) { s2[r] = MASKV; s3[r] = MASKV; }
        }
        softmax_rel2(s0_, s1, s2, s3, p == 0, m_run, cm, lacc, o, wsf, lane);
        if (!late) { pv_tile_l<true>(lds + AT_V + vst * 8192, lane, s0_, s1, o, lacc, ones); if (two) pv_tile_l<true>(lds + AT_V + (vst + 1) * 8192, lane, s2, s3, o, lacc, ones); }
        asm volatile("s_waitcnt vmcnt(0) lgkmcnt(0)" ::: "memory");
        __builtin_amdgcn_s_barrier(); asm volatile("" ::: "memory");
        if (late) { pv_tile_l<true>(lds + AT_V + vst * 8192, lane, s0_, s1, o, lacc, ones); if (two) pv_tile_l<true>(lds + AT_V + (vst + 1) * 8192, lane, s2, s3, o, lacc, ones); }
        cs = cn;
    }
#pragma unroll
    for (int r = 0; r < 16; ++r) { const float rl = __builtin_amdgcn_rcpf(lacc[r]); o[0][r] *= rl; o[1][r] *= rl; }
    return cs;
}
#define A2_SBAR() __builtin_amdgcn_sched_barrier(0)
#define A2_PIN(x) asm volatile("" : "+v"(x))
#define A2_MFMA(a, b, c) __builtin_amdgcn_mfma_f32_32x32x16_bf16(a, b, c, 0, 0, 0)
template <bool SEL, class PostF>
__device__ __forceinline__ float attn_stream2(LAS unsigned char* lds, const bf16_t* Kp, const bf16_t* Vp, long row0, int g, int nt, int tid, int lane, const bf16x8 (&qr)[4], LAS float* wsf,
                                             f32x16 (&o)[2], unsigned mysel, const PostF& post) {
    const int r32 = lane & 31, hi = lane >> 5; const int wid = __builtin_amdgcn_readfirstlane(tid >> 6);
    const int key = 8 * wid + (lane >> 3), s16 = lane & 7;
    const bf16_t* ksrc = Kp + (row0 + key) * 256 + g * 64 + k_src_chunk(key, s16) * 8;
    const bf16_t* vsrc = Vp + (row0 + key) * 256 + g * 64 + v_src_chunk(key, s16) * 8;
    const unsigned l0 = (unsigned)(size_t)lds, kdst = l0 + AT_K + wid * 1024, vdst = l0 + AT_V + wid * 1024;
#define A2_DMA_K(t_, so_) glds16(ksrc + (long)(t_) * 64 * 256, (unsigned)__builtin_amdgcn_readfirstlane(kdst + (so_)))
#define A2_DMA_V(t_, so_) glds16(vsrc + (long)(t_) * 64 * 256, (unsigned)__builtin_amdgcn_readfirstlane(vdst + (so_)))
    int kb[4];
#pragma unroll
    for (int d0 = 0; d0 < 4; ++d0) kb[d0] = AT_K + k_frag_off(r32, 2 * d0 + hi);
    const int qp = (lane & 15) >> 2, sw = (qp >> 1) & 1;
    const int vb = AT_V + (4 * hi + qp) * 128 + ((lane >> 4) & 1) * 32 + (lane & 3) * 8, vba = vb + (sw << 6), vbb = vb + ((sw ^ 1) << 6);
    constexpr int SLOTB = 8192;
    A2_DMA_K(0, 0); A2_DMA_V(0, 0); if (nt > 1) A2_DMA_K(1, SLOTB); if (nt > 2) A2_DMA_K(2, 2 * SLOTB);
    float mhat = 0.f, l_reg = 0.f;
#pragma unroll
    for (int r = 0; r < 16; ++r) { o[0][r] = 0.f; o[1][r] = 0.f; }
    f32x16 cm;
#pragma unroll
    for (int r = 0; r < 16; ++r) cm[r] = 0.f;
    A2_PIN(cm);
    f32x16 pA0, pA1, pB0, pB1; bf16x8 kf[8]; v4i16_t vlo[8], vhi[8]; u32x4 pw0, pw1, pw2, pw3; bool resc = false;
    int sl_prev = 0, sl_cur = 0, sl_next = SLOTB;
#define A2_ROT() do { sl_prev = sl_cur; sl_cur = sl_next; sl_next = (sl_next == 2 * SLOTB) ? 0 : sl_next + SLOTB; } while (0)
#define A2_KLD2(d0_, so_) do { kf[2 * (d0_)] = *(const LAS bf16x8*)(lds + kb[d0_] + (so_)); kf[2 * (d0_) + 1] = *(const LAS bf16x8*)(lds + kb[d0_] + (so_) + 4096); } while (0)
#define A2_CI(t_, CI) do { const bool s_ = !SEL || ((mysel >> (t_)) & 1u) != 0u; _Pragma("unroll") for (int r = 0; r < 16; ++r) CI[r] = s_ ? cm[r] : MASKV; } while (0)
#define A2_RESC() do { if (resc) { asm volatile("s_waitcnt lgkmcnt(0)" ::: "memory"); _Pragma("unroll") for (int r4 = 0; r4 < 4; ++r4) { const f32x4 a4 = *(const LAS f32x4*)(wsf + 8 * r4 + 4 * hi); \
        _Pragma("unroll") for (int j = 0; j < 4; ++j) { o[0][4 * r4 + j] *= a4[j]; o[1][4 * r4 + j] *= a4[j]; } } } } while (0)
    asm volatile("s_waitcnt vmcnt(0)" ::: "memory"); __builtin_amdgcn_s_barrier(); asm volatile("" ::: "memory");
    { f32x16 ci; A2_CI(0, ci); qk_tile_c(lds + AT_K, qr, r32, hi, ci, pA0, pA1); post(0, pA0, pA1);
      asm volatile("s_nop 15" : "+v"(pA0), "+v"(pA1));
      float a = max3f(pA0[0], pA0[1], pA0[2]), b2 = max3f(pA1[0], pA1[1], pA1[2]);
#pragma unroll
      for (int r = 3; r < 15; r += 2) { a = max3f(a, pA0[r], pA0[r + 1]); b2 = max3f(b2, pA1[r], pA1[r + 1]); }
      float rm = max3f(a, b2, pA0[15]); rm = max3f(rm, pA1[15], pA1[15]); rm = xhalf_max(rm);
      const float dl = (rm > -1.0e29f) ? rm : 0.f; mhat = dl;
#pragma unroll
      for (int r = 0; r < 16; ++r) { pA0[r] = __builtin_amdgcn_exp2f(pA0[r] - dl); pA1[r] = __builtin_amdgcn_exp2f(pA1[r] - dl); cm[r] = -mhat; }
      A2_PIN(cm); }
    if (nt > 1) {
#pragma unroll
        for (int d0 = 0; d0 < 4; ++d0) A2_KLD2(d0, SLOTB);
    }
    asm volatile("s_waitcnt lgkmcnt(0)" ::: "memory"); __builtin_amdgcn_s_barrier(); asm volatile("" ::: "memory");
    if (nt > 3) A2_DMA_K(3, 0);
    if (nt > 1) A2_DMA_V(1, SLOTB);
    A2_ROT();
#define A2_PKW(P, i) pk2(P[i], P[i + 1])
#define A2_PAF(k_) __builtin_bit_cast(bf16x8, pw##k_)
#define A2_VFR(i) (bf16x8){vlo[i][0], vlo[i][1], vlo[i][2], vlo[i][3], vhi[i][0], vhi[i][1], vhi[i][2], vhi[i][3]}
#define A2_VRD(i) do { const LAS unsigned char* p_ = lds + (((i) >> 2) ? vbb : vba) + sl_prev + ((i) & 3) * 2048; vlo[i] = __builtin_amdgcn_ds_read_tr16_b64_v4i16((LAS v4i16_t*)p_); vhi[i] = __builtin_amdgcn_ds_read_tr16_b64_v4i16((LAS v4i16_t*)(p_ + 1024)); } while (0)
#define A2_KRD(G_, d0_) do { if (G_) { A2_KLD2(d0_, sl_next); A2_SBAR(); } } while (0)
#define A2_GAPA(MF, a0, a1, a2, a3, W0, W1, PW) do { MF; sacc += a0; sacc += a1; sacc += a2; sacc += a3; A2_PIN(sacc); W0; W1; A2_PIN(PW); A2_SBAR(); } while (0)
#define A2_GAPB(MF, X, i) do { MF; X[i] = __builtin_amdgcn_exp2f(X[i]); X[i + 1] = __builtin_amdgcn_exp2f(X[i + 1]); X[i + 2] = __builtin_amdgcn_exp2f(X[i + 2]); X[i + 3] = __builtin_amdgcn_exp2f(X[i + 3]); A2_PIN(X); A2_SBAR(); } while (0)
#define A2_STEP(C0, C1, P0, P1, t_) do { const int tt_ = (t_); const bool GK_ = tt_ + 3 < nt, GV_ = tt_ + 1 < nt; \
    f32x16 ci_; if (SEL) { A2_CI(tt_, ci_); A2_PIN(ci_); } A2_SBAR(); \
    A2_VRD(0); A2_SBAR(); float sacc = P0[0] + P0[1]; \
                       A2_GAPA(C0 = A2_MFMA(kf[0], qr[0], SEL ? ci_ : cm), P0[2], P0[3], P0[4], P0[5],     pw0[0] = A2_PKW(P0, 0),  pw0[1] = A2_PKW(P0, 2),  pw0); \
    A2_VRD(4); A2_SBAR(); A2_GAPA(C1 = A2_MFMA(kf[1], qr[0], SEL ? ci_ : cm), P0[6], P0[7], P0[8], P0[9],     pw0[2] = A2_PKW(P0, 4),  pw0[3] = A2_PKW(P0, 6),  pw0); \
    A2_VRD(1); A2_SBAR(); A2_GAPA(C0 = A2_MFMA(kf[2], qr[1], C0),  P0[10], P0[11], P0[12], P0[13], pw1[0] = A2_PKW(P0, 8),  pw1[1] = A2_PKW(P0, 10), pw1); \
    A2_VRD(5); A2_SBAR(); A2_GAPA(C1 = A2_MFMA(kf[3], qr[1], C1),  P0[14], P0[15], P1[0], P1[1],   pw1[2] = A2_PKW(P0, 12), pw1[3] = A2_PKW(P0, 14), pw1); \
    A2_VRD(2); A2_SBAR(); A2_GAPA(C0 = A2_MFMA(kf[4], qr[2], C0),  P1[2], P1[3], P1[4], P1[5],     pw2[0] = A2_PKW(P1, 0),  pw2[1] = A2_PKW(P1, 2),  pw2); \
    A2_VRD(6); A2_SBAR(); A2_GAPA(C1 = A2_MFMA(kf[5], qr[2], C1),  P1[6], P1[7], P1[8], P1[9],     pw2[2] = A2_PKW(P1, 4),  pw2[3] = A2_PKW(P1, 6),  pw2); \
    A2_VRD(3); A2_SBAR(); A2_GAPA(C0 = A2_MFMA(kf[6], qr[3], C0),  P1[10], P1[11], P1[12], P1[13], pw3[0] = A2_PKW(P1, 8),  pw3[1] = A2_PKW(P1, 10), pw3); \
    A2_VRD(7); A2_SBAR(); A2_GAPA(C1 = A2_MFMA(kf[7], qr[3], C1),  P1[14], P1[15], 0.f, 0.f,       pw3[2] = A2_PKW(P1, 12), pw3[3] = A2_PKW(P1, 14), pw3); \
    l_reg += sacc; \
    if (GK_) A2_DMA_K(tt_ + 3, sl_cur); if (GV_) A2_DMA_V(tt_ + 1, sl_next); \
    post(tt_, C0, C1); \
    { asm volatile("s_nop 15" : "+v"(C0), "+v"(C1)); \
      float a_ = max3f(C0[0], C0[1], C0[2]), b_ = max3f(C1[0], C1[1], C1[2]); \
      _Pragma("unroll") for (int r = 3; r < 15; r += 2) { a_ = max3f(a_, C0[r], C0[r + 1]); b_ = max3f(b_, C1[r], C1[r + 1]); } \
      float rm_ = max3f(a_, b_, C0[15]); rm_ = max3f(rm_, C1[15], C1[15]); rm_ = xhalf_max(rm_); resc = false; \
      if (__builtin_expect(__any(rm_ > RESC_THR), 0)) { const float dl_ = fmaxf(rm_, 0.f); mhat += dl_; \
          _Pragma("unroll") for (int r = 0; r < 16; ++r) { C0[r] -= dl_; C1[r] -= dl_; cm[r] = -mhat; } A2_PIN(cm); \
          const float f_ = __builtin_amdgcn_exp2f(-dl_); l_reg *= f_; if (hi == 0) wsf[r32] = f_; resc = true; } } \
    A2_SBAR(); \
    A2_GAPB(o[0] = A2_MFMA(A2_PAF(0), A2_VFR(0), o[0]), C0, 0);               A2_GAPB(o[1] = A2_MFMA(A2_PAF(0), A2_VFR(4), o[1]), C0, 4); \
    A2_KRD(GV_, 0); A2_GAPB(o[0] = A2_MFMA(A2_PAF(1), A2_VFR(1), o[0]), C0, 8);  A2_KRD(GV_, 1); A2_GAPB(o[1] = A2_MFMA(A2_PAF(1), A2_VFR(5), o[1]), C0, 12); \
    A2_KRD(GV_, 2); A2_GAPB(o[0] = A2_MFMA(A2_PAF(2), A2_VFR(2), o[0]), C1, 0);  A2_KRD(GV_, 3); A2_GAPB(o[1] = A2_MFMA(A2_PAF(2), A2_VFR(6), o[1]), C1, 4); \
    A2_GAPB(o[0] = A2_MFMA(A2_PAF(3), A2_VFR(3), o[0]), C1, 8);               A2_GAPB(o[1] = A2_MFMA(A2_PAF(3), A2_VFR(7), o[1]), C1, 12); \
    if (GK_ && GV_) asm volatile("s_waitcnt vmcnt(2) lgkmcnt(0)\n\ts_barrier" ::: "memory"); else if (GV_) asm volatile("s_waitcnt vmcnt(1) lgkmcnt(0)\n\ts_barrier" ::: "memory"); else asm volatile("s_waitcnt vmcnt(0) lgkmcnt(0)\n\ts_barrier" ::: "memory"); \
    A2_RESC(); A2_ROT(); } while (0)
#define A2_DRAIN(P0, P1) do { float sacc = P0[0] + P0[1]; \
      _Pragma("unroll") for (int r = 2; r < 16; ++r) sacc += P0[r]; \
      _Pragma("unroll") for (int r = 0; r < 16; ++r) sacc += P1[r]; \
      l_reg += sacc; \
      pw0 = (u32x4){A2_PKW(P0, 0), A2_PKW(P0, 2), A2_PKW(P0, 4), A2_PKW(P0, 6)}; pw1 = (u32x4){A2_PKW(P0, 8), A2_PKW(P0, 10), A2_PKW(P0, 12), A2_PKW(P0, 14)}; \
      pw2 = (u32x4){A2_PKW(P1, 0), A2_PKW(P1, 2), A2_PKW(P1, 4), A2_PKW(P1, 6)}; pw3 = (u32x4){A2_PKW(P1, 8), A2_PKW(P1, 10), A2_PKW(P1, 12), A2_PKW(P1, 14)}; \
      _Pragma("unroll") for (int i = 0; i < 8; ++i) A2_VRD(i); \
      o[0] = A2_MFMA(A2_PAF(0), A2_VFR(0), o[0]); o[1] = A2_MFMA(A2_PAF(0), A2_VFR(4), o[1]); o[0] = A2_MFMA(A2_PAF(1), A2_VFR(1), o[0]); o[1] = A2_MFMA(A2_PAF(1), A2_VFR(5), o[1]); \
      o[0] = A2_MFMA(A2_PAF(2), A2_VFR(2), o[0]); o[1] = A2_MFMA(A2_PAF(2), A2_VFR(6), o[1]); o[0] = A2_MFMA(A2_PAF(3), A2_VFR(3), o[0]); o[1] = A2_MFMA(A2_PAF(3), A2_VFR(7), o[1]); } while (0)
    int t = 1;
#pragma unroll 1
    for (; t + 1 < nt; t += 2) { A2_STEP(pB0, pB1, pA0, pA1, t); A2_STEP(pA0, pA1, pB0, pB1, t + 1); }
    if (t < nt) { A2_STEP(pB0, pB1, pA0, pA1, t); A2_DRAIN(pB0, pB1); } else { A2_DRAIN(pA0, pA1); }
    asm volatile("s_waitcnt lgkmcnt(0)" ::: "memory"); __builtin_amdgcn_s_barrier(); asm volatile("" ::: "memory");
#undef A2_DMA_K
#undef A2_DMA_V
#undef A2_ROT
#undef A2_KLD2
#undef A2_CI
#undef A2_RESC
#undef A2_PKW
#undef A2_PAF
#undef A2_VFR
#undef A2_VRD
#undef A2_KRD
#undef A2_GAPA
#undef A2_GAPB
#undef A2_STEP
#undef A2_DRAIN
    return xhalf_sum(l_reg);
}
__device__ __forceinline__ void acc_scaled(LAS float* oaccL, const f32x16 (&o)[2], float f, LAS float* wsf, int lane, bool init) {
    const int q = lane & 31, hi = lane >> 5;
    if (hi == 0) wsf[32 + q] = f;
    asm volatile("s_waitcnt lgkmcnt(0)" ::: "memory");
#pragma unroll
    for (int r4 = 0; r4 < 4; ++r4) { const f32x4 a4 = *(const LAS f32x4*)(wsf + 32 + 8 * r4 + 4 * hi);
#pragma unroll
        for (int j = 0; j < 4; ++j) { const int r = 4 * r4 + j; LAS float* p0 = oaccL + r * 64 + lane; LAS float* p1 = oaccL + (16 + r) * 64 + lane;
            if (init) { *p0 = a4[j] * o[0][r]; *p1 = a4[j] * o[1][r]; } else { *p0 += a4[j] * o[0][r]; *p1 += a4[j] * o[1][r]; } } }
    asm volatile("s_waitcnt lgkmcnt(0)" ::: "memory");
}

__device__ __forceinline__ void acc_final_store(LAS float* oaccL, const f32x16 (&o)[2], float f, LAS float* wsf, int lane, bf16_t* Ow, bool wt) {
    const int q = lane & 31, hi = lane >> 5;
    if (hi == 0) wsf[32 + q] = f;
    asm volatile("s_waitcnt lgkmcnt(0)" ::: "memory");
    f32x16 r0, r1;
#pragma unroll
    for (int r4 = 0; r4 < 4; ++r4) { const f32x4 a4 = *(const LAS f32x4*)(wsf + 32 + 8 * r4 + 4 * hi);
#pragma unroll
        for (int j = 0; j < 4; ++j) { const int r = 4 * r4 + j; r0[r] = oaccL[r * 64 + lane] + a4[j] * o[0][r]; r1[r] = oaccL[(16 + r) * 64 + lane] + a4[j] * o[1][r]; } }
    asm volatile("s_waitcnt lgkmcnt(0)" ::: "memory");
    LAS bf16_t* stg = (LAS bf16_t*)oaccL;
#pragma unroll
    for (int r = 0; r < 16; ++r) { const int orow = crow(r, hi); stg[orow * 64 + q] = (bf16_t)f2bf(r0[r]); stg[orow * 64 + 32 + q] = (bf16_t)f2bf(r1[r]); }
    asm volatile("s_waitcnt lgkmcnt(0)" ::: "memory");
#pragma unroll
    for (int i = 0; i < 4; ++i) { const int row = i * 8 + (lane >> 3), ch = lane & 7; const u32x4 v = *(const LAS u32x4*)(stg + row * 64 + ch * 8); if (wt) store16_wt(Ow + (long)row * 1024 + ch * 8, v); else *(u32x4*)(Ow + (long)row * 1024 + ch * 8) = v; }
    asm volatile("s_waitcnt lgkmcnt(0)" ::: "memory");
}

typedef int i32x4 __attribute__((ext_vector_type(4)));
__device__ __forceinline__ void cnt_gt(int& cnt, int a, int b) { asm("v_cmp_gt_i32_e32 vcc, %1, %2\n\tv_addc_co_u32_e32 %0, vcc, 0, %0, vcc" : "+v"(cnt) : "v"(a), "v"(b) : "vcc"); }
__device__ __forceinline__ int attn_item(Frame& F, const AttnPtrs& P, int b, int g, int qt, int cs, int nb_, int ng_, int prev_pm, int mode = 0) {
    LAS unsigned char* lds = F.lds;
    int tid = threadIdx.x; asm volatile("" : "+v"(tid)); int lane = tid & 63; const int w = __builtin_amdgcn_readfirstlane(tid >> 6), hd = w & 3, sb = w >> 2; int q = lane & 31, hi = lane >> 5;
    const int t0 = qt * 64, ql = 32 * sb + q, tq = t0 + ql;
#define RELAUNDER() do { tid = threadIdx.x; asm volatile("" : "+v"(tid)); lane = tid & 63; q = lane & 31; hi = lane >> 5; } while (0)
    const long rowq = (long)b * S + tq;
    const int head = g * 4 + hd;
    LAS float* wsf = (LAS float*)(lds + AT_WSF) + w * 64;
    LAS float* Psum = (LAS float*)(lds + AT_PSUM);
    LAS float* scr = (LAS float*)(lds + AT_SCR);
    LAS unsigned* selm = (LAS unsigned*)(lds + AT_SELM);
    bf16x8 qr[4];
#pragma unroll
    for (int d0 = 0; d0 < 4; ++d0) qr[d0] = *(const bf16x8*)(P.Q + rowq * 1024 + head * 64 + d0 * 16 + hi * 8);
    LAS float* oaccL = (LAS float*)(lds + AT_OACC) + w * 2048;
    const float* ngp = P.NG + ((long)b * S + t0 + 32 * sb + q) * 48 + head; const float g_cmp = ngp[0], g_sel = ngp[16], g_win = ngp[32];
    const int wkt0 = qt >= 8 ? qt - 8 : 0, wnt = qt - wkt0 + 1;
    const LAS unsigned char* cK = lds + AT_K; const LAS unsigned char* cV = lds + AT_V;
    {
        RELAUNDER();
        kv_dma(lds, 0, 0, P.KC, P.VC, (long)b * 128, g, tid); kv_dma(lds, 1, 1, P.KC, P.VC, (long)b * 128 + 64, g, tid);
        asm volatile("s_waitcnt vmcnt(0)" ::: "memory"); __builtin_amdgcn_s_barrier(); asm volatile("" ::: "memory");
        if (P.ordy && prev_pm >= 0 && tid == 0) __hip_atomic_fetch_add(P.ordy + 4 * prev_pm, 1u, __ATOMIC_RELAXED, __HIP_MEMORY_SCOPE_AGENT);
        const int nlim0 = min((tq - 31) >> 4, 126);
#define CMP_MASK(kt_, P0, P1) do { int nl_ = nlim0 - 64 * (kt_); asm volatile("" : "+v"(nl_)); _Pragma("unroll") for (int r = 0; r < 16; ++r) { const int n = crow(r, hi); \
            P0[r] = (n <= nl_) ? P0[r] : MASKV; P1[r] = (n + 32 <= nl_) ? P1[r] : MASKV; } } while (0)
        f32x16 p0, p1, p2, p3;
        qk_tile(cK, qr, q, hi, p0, p1); CMP_MASK(0, p0, p1);
        qk_tile(cK + 8192, qr, q, hi, p2, p3); CMP_MASK(1, p2, p3);
#undef CMP_MASK
        float mt = fmaxf(fmaxf(p0[0], p1[0]), fmaxf(p2[0], p3[0]));
#pragma unroll
        for (int r = 1; r < 16; ++r) mt = fmaxf(fmaxf(mt, fmaxf(p0[r], p1[r])), fmaxf(p2[r], p3[r]));
        mt = xhalf_max(mt);
        float sum = 0.f;
#pragma unroll
        for (int r = 0; r < 16; ++r) { p0[r] = __builtin_amdgcn_exp2f(p0[r] - mt); p1[r] = __builtin_amdgcn_exp2f(p1[r] - mt); p2[r] = __builtin_amdgcn_exp2f(p2[r] - mt); p3[r] = __builtin_amdgcn_exp2f(p3[r] - mt);
            sum += (p0[r] + p1[r]) + (p2[r] + p3[r]); }
        sum = xhalf_sum(sum);
        const float rl = (tq >= 31) ? 1.0f / sum : 0.f;
#pragma unroll
        for (int r = 0; r < 16; ++r) { p0[r] *= rl; p1[r] *= rl; p2[r] *= rl; p3[r] *= rl; }
        {
            float lastv[16], fromA[16], fromB[16];
#pragma unroll
            for (int j = 0; j < 4; ++j)
#pragma unroll
                for (int i = 0; i < 4; ++i) { const float xl = (j == 0) ? p0[4 * i + 3] : (j == 1) ? p1[4 * i + 3] : (j == 2) ? p2[4 * i + 3] : p3[4 * i + 3];
                    lastv[4 * j + i] = xl; float a = xl, b2 = xl; swap32(a, b2); fromA[4 * j + i] = a; fromB[4 * j + i] = b2; }
            LAS float* ph = Psum + hd * (64 * 33) + ql * 33;
#pragma unroll
            for (int j = 0; j < 4; ++j)
#pragma unroll
                for (int i = 0; i < 4; ++i) { const int e = 4 * j + i;
                    const float q0 = (j == 0) ? p0[4 * i] : (j == 1) ? p1[4 * i] : (j == 2) ? p2[4 * i] : p3[4 * i];
                    const float q1 = (j == 0) ? p0[4 * i + 1] : (j == 1) ? p1[4 * i + 1] : (j == 2) ? p2[4 * i + 1] : p3[4 * i + 1];
                    const float q2 = (j == 0) ? p0[4 * i + 2] : (j == 1) ? p1[4 * i + 2] : (j == 2) ? p2[4 * i + 2] : p3[4 * i + 2];
                    const float prevLo = (e == 0) ? 0.f : fromB[e - 1];
                    const float prev = hi ? fromA[e] : prevLo;
                    ph[2 * i + hi + 8 * j] = (q0 + q1) + (q2 + 0.5f * lastv[e]) + 0.5f * prev; }
        }
        __syncthreads();
        f32x16 o[2];
#pragma unroll
        for (int r = 0; r < 16; ++r) { o[0][r] = 0.f; o[1][r] = 0.f; }
        pv_tile(cV, lane, p0, p1, o); pv_tile(cV + 8192, lane, p2, p3, o);
        {
            const int tk = tid >> 3, mg = tid & 7;
            const LAS float* pr = Psum + tk * 33;
            float sc4[4];
#pragma unroll
            for (int j = 0; j < 4; ++j) {
                const int m = 4 * mg + j;
                const float ps = (pr[m] + pr[64 * 33 + m]) + (pr[2 * 64 * 33 + m] + pr[3 * 64 * 33 + m]);
                const bool allowed = m <= qt, forced = (m == 0) || (m == qt) || (m == qt - 1);
                sc4[j] = allowed ? (ps + (forced ? 1.0e4f : 0.f)) : -1.0f;
                scr[tk * 32 + m] = sc4[j];
            }
            __syncthreads();
            int key4[4], rank[4];
#pragma unroll
            for (int j = 0; j < 4; ++j) { key4[j] = __builtin_bit_cast(int, sc4[j]); rank[j] = 0; }
            const LAS i32x4* kp = (const LAS i32x4*)(scr + tk * 32);
#pragma unroll
            for (int g2 = 0; g2 < 8; ++g2) {
                const i32x4 kv = kp[g2]; const int adj = (g2 < mg) ? 1 : 0;
#pragma unroll
                for (int j = 0; j < 4; ++j) { const int thr = key4[j] - adj;
#pragma unroll
                    for (int j2 = 0; j2 < 4; ++j2) cnt_gt(rank[j], kv[j2], thr); }
            }
            rank[1] += (key4[0] == key4[1]) ? 1 : 0;
            rank[2] += ((key4[0] == key4[2]) ? 1 : 0) + ((key4[1] == key4[2]) ? 1 : 0);
            rank[3] += ((key4[0] == key4[3]) ? 1 : 0) + ((key4[1] == key4[3]) ? 1 : 0) + ((key4[2] == key4[3]) ? 1 : 0);
            unsigned bits = 0u;
#pragma unroll
            for (int j = 0; j < 4; ++j) { const int m = 4 * mg + j; if (rank[j] < 16 && m <= qt) bits |= 1u << m; }
            bits |= swz_xor<1>(bits); bits |= swz_xor<2>(bits); bits |= swz_xor<4>(bits);
            if (mg == 0) selm[tk] = bits;
        }
        __syncthreads();
        acc_scaled(oaccL, o, g_cmp, wsf, lane, true);
    }
    const unsigned mysel = selm[ql];
    {
        RELAUNDER();
        const int kt0 = wkt0, nt = wnt;
        f32x16 o[2];
        auto post = [&](int it, f32x16& p0, f32x16& p1) {
            if (it == 0 || it == nt - 1) {
                int dq = tq - 64 * (kt0 + it); asm volatile("" : "+v"(dq));
#pragma unroll
                for (int r = 0; r < 16; ++r) { const int x0 = dq - crow(r, hi), x1 = x0 - 32;
                    p0[r] = mask_neg(p0[r], x0 | (511 - x0)); p1[r] = mask_neg(p1[r], x1 | (511 - x1)); }
            }
        };
        float lt = 1.f;
#pragma unroll
        for (int r = 0; r < 16; ++r) { o[0][r] = 0.f; o[1][r] = 0.f; }
        if (!(mode & 1)) lt = attn_stream2<false>(lds, P.KW, P.VW, (long)b * S + 64 * kt0, g, nt, tid, lane, qr, wsf, o, 0u, post);
        acc_scaled(oaccL, o, g_win / lt, wsf, lane, false);
    }
    {
        RELAUNDER();
        const int nt = qt + 1;
        f32x16 o[2];
        auto post = [&](int kt, f32x16& p0, f32x16& p1) {
            if (kt == qt) {
                int qlim = ql; asm volatile("" : "+v"(qlim));
#pragma unroll
                for (int r = 0; r < 16; ++r) { const int kl = crow(r, hi); p0[r] = mask_neg(p0[r], qlim - kl); p1[r] = mask_neg(p1[r], qlim - kl - 32); }
            }
        };
        float lt = 1.f;
#pragma unroll
        for (int r = 0; r < 16; ++r) { o[0][r] = 0.f; o[1][r] = 0.f; }
        if (!(mode & 2)) lt = attn_stream2<true>(lds, P.KS, P.VS, (long)b * S, g, nt, tid, lane, qr, wsf, o, mysel, post);
        RELAUNDER();
        acc_final_store(oaccL, o, g_sel / lt, wsf, lane, P.O + ((long)b * S + t0 + 32 * sb) * 1024 + head * 64, P.ordy != nullptr);
    }
    asm volatile("s_waitcnt lgkmcnt(0)" ::: "memory"); __builtin_amdgcn_s_barrier(); asm volatile("" ::: "memory");
    return 0;
#undef RELAUNDER
}
__device__ __forceinline__ void attn_phase(Frame& F, const AttnPtrs& P, int mode = 0) {
    const int vcu = (F.G % 8 == 0) ? (F.bid % 8) * (F.G / 8) + F.bid / 8 : F.bid;
    const int pr0 = vcu >> 3, prs = F.G >> 3, npr = P.nb * 4;
    int cs = 0, prev_pm = -1;
    for (int pr = pr0; pr < npr; pr += prs) {
        const int b = pr >> 2, g = pr & 3, s8 = vcu & 7;
        if (P.ready) {
            if (threadIdx.x < 64) {
                unsigned sp = 0;
                while ((unsigned)__builtin_amdgcn_readfirstlane(__hip_atomic_load(P.ready + 8 * pr, __ATOMIC_RELAXED, __HIP_MEMORY_SCOPE_AGENT)) < 8u) { __builtin_amdgcn_s_sleep(2); if (++sp > (1u << 22)) break; }
                __builtin_amdgcn_fence(__ATOMIC_ACQUIRE, "agent");
            }
            __syncthreads();
        }
        for (int i = 0; i < 4; ++i) { const int qt = (i == 0) ? s8 : (i == 1) ? 15 - s8 : (i == 2) ? 16 + s8 : 31 - s8;
            const int npr_ = (i < 3) ? pr : pr + prs; const int nb_ = (npr_ < npr) ? (npr_ >> 2) : -1, ng_ = npr_ & 3;
            cs = attn_item(F, P, b, g, qt, cs, nb_, ng_, prev_pm, mode); prev_pm = b * 8 + (qt >> 2); }
    }
    __syncthreads();
    if (P.ordy && prev_pm >= 0 && threadIdx.x == 0) __hip_atomic_fetch_add(P.ordy + 4 * prev_pm, 1u, __ATOMIC_RELAXED, __HIP_MEMORY_SCOPE_AGENT);
}
struct LruPtrs { const bf16_t* XR; const bf16_t* GG; bf16_t* GAo; const float *cw, *cb, *ba, *bi, *lam; const bf16_t *WaT, *WiT; float* AGG; int nb; unsigned* ready; };
constexpr int LR_XS = 0, LR_XC = 33792, LR_XCS = 68  , LR_A = LR_XC + 128 * LR_XCS * 4, LR_SEG = LR_A + 32768, LR_CIN = LR_SEG + 4096, LR_END = LR_CIN + 256;
static_assert(LR_END <= STAGE_BYTES, "lru LDS map");
__device__ __forceinline__ float fast_sigmoid(float x) { return __builtin_amdgcn_rcpf(1.0f + __builtin_amdgcn_exp2f(-1.4426950408889634f * x)); }
template <int PASS>
__device__ __forceinline__ void lru_item(Frame& F, const LruPtrs& P, int b, int hb, int ch) {
    LAS unsigned char* lds = F.lds;
    int tid = threadIdx.x; asm volatile("" : "+v"(tid));
    const int lane = tid & 63, w = __builtin_amdgcn_readfirstlane(tid >> 6);
    LAS float* xs = (LAS float*)(lds + LR_XS); LAS float* xc = (LAS float*)(lds + LR_XC); LAS float* ab = (LAS float*)(lds + LR_A);
    LAS float* segA = (LAS float*)(lds + LR_SEG); LAS float* segH = segA + 512; LAS float* cin = (LAS float*)(lds + LR_CIN);
    const int c0 = ch * 128; const long rowb = (long)b * S;
    for (int i = tid; i < 131 * 8; i += 512) {
        const int row = i >> 3, c8 = i & 7, t = c0 - 3 + row;
        u32x4 v = (u32x4){0u, 0u, 0u, 0u};
        if (t >= 0) v = *(const u32x4*)(P.XR + (rowb + t) * 1024 + hb * 64 + c8 * 8);
        f32x4 lo, hi4;
        lo[0] = __builtin_bit_cast(float, v.x << 16); lo[1] = __builtin_bit_cast(float, v.x & 0xffff0000u); lo[2] = __builtin_bit_cast(float, v.y << 16); lo[3] = __builtin_bit_cast(float, v.y & 0xffff0000u);
        hi4[0] = __builtin_bit_cast(float, v.z << 16); hi4[1] = __builtin_bit_cast(float, v.z & 0xffff0000u); hi4[2] = __builtin_bit_cast(float, v.w << 16); hi4[3] = __builtin_bit_cast(float, v.w & 0xffff0000u);
        *(LAS f32x4*)(xs + row * 64 + c8 * 8) = lo; *(LAS f32x4*)(xs + row * 64 + c8 * 8 + 4) = hi4;
    }
    __syncthreads();
    {
        const int c = tid & 63, cg = hb * 64 + c;
        const float w0 = P.cw[cg], w1 = P.cw[1024 + cg], w2 = P.cw[2048 + cg], w3 = P.cw[3072 + cg], bb = P.cb[cg];
#pragma unroll 4
        for (int i = 0; i < 16; ++i) { const int t = (tid >> 6) + 8 * i;
            xc[t * LR_XCS + c] = bb + w0 * xs[t * 64 + c] + w1 * xs[(t + 1) * 64 + c] + w2 * xs[(t + 2) * 64 + c] + w3 * xs[(t + 3) * 64 + c]; }
    }
    __syncthreads();
    {
        const int fr = lane & 15, fq = lane >> 4;
        bf16x8 af[2];
#pragma unroll
        for (int kk = 0; kk < 2; ++kk) { const LAS float* xp = xc + (16 * w + fr) * LR_XCS + kk * 32 + 8 * fq; const f32x4 x0 = *(const LAS f32x4*)xp, x1 = *(const LAS f32x4*)(xp + 4);
            u32x4 pk; pk.x = pk2(x0[0], x0[1]); pk.y = pk2(x0[2], x0[3]); pk.z = pk2(x1[0], x1[1]); pk.w = pk2(x1[2], x1[3]); af[kk] = __builtin_bit_cast(bf16x8, pk); }
#pragma unroll
        for (int nt = 0; nt < 4; ++nt) {
            f32x4 R = (f32x4){0.f, 0.f, 0.f, 0.f}, I = (f32x4){0.f, 0.f, 0.f, 0.f};
#pragma unroll
            for (int kk = 0; kk < 2; ++kk) {
                const size_t wo = ((size_t)(hb * 64 + nt * 16 + fr)) * 64 + kk * 32 + 8 * fq;
                const bf16x8 wa = *(const bf16x8*)(P.WaT + wo), wi = *(const bf16x8*)(P.WiT + wo);
                R = __builtin_amdgcn_mfma_f32_16x16x32_bf16(af[kk], wa, R, 0, 0, 0);
                I = __builtin_amdgcn_mfma_f32_16x16x32_bf16(af[kk], wi, I, 0, 0, 0);
            }
            const int cl = nt * 16 + fr, cg = hb * 64 + cl;
            const float bav = P.ba[cg], biv = P.bi[cg], nl = -P.lam[cg];
            const float sp = fmaxf(nl, 0.f) + log1pf(expf(-fabsf(nl)));
#pragma unroll
            for (int r = 0; r < 4; ++r) {
                const int tl = 16 * w + 4 * fq + r;
                const float rg = fast_sigmoid(R[r] + bav), ig = fast_sigmoid(I[r] + biv);
                const float log_a = -8.0f * rg * sp;
                const float a = expf(log_a), u = sqrtf(-expm1f(2.0f * log_a)) * (ig * xc[tl * LR_XCS + cl]);
                ab[tl * 64 + cl] = a; xc[tl * LR_XCS + cl] = u;
            }
        }
    }
    __syncthreads();
    const int c = lane, seg = w;
    {
        float A = 1.f, H = 0.f;
#pragma unroll 4
        for (int i = 0; i < 16; ++i) { const int t = seg * 16 + i; const float a = ab[t * 64 + c], u = xc[t * LR_XCS + c]; H = a * H + u; A *= a; }
        segA[seg * 64 + c] = A; segH[seg * 64 + c] = H;
    }
    __syncthreads();
    if (PASS == 1) {
        if (tid < 64) { float A = 1.f, H = 0.f;
#pragma unroll
            for (int s2 = 0; s2 < 8; ++s2) { const float a = segA[s2 * 64 + tid], h = segH[s2 * 64 + tid]; H = a * H + h; A *= a; }
            float* ag = P.AGG + (((size_t)b * 16 + ch) * 1024 + hb * 64 + tid) * 2; ag[0] = A; ag[1] = H; }
        __syncthreads();
    } else {
        if (tid < 64) { float h = 0.f;
            for (int k2 = 0; k2 < ch; ++k2) { const float* ag = P.AGG + (((size_t)b * 16 + k2) * 1024 + hb * 64 + tid) * 2; h = ag[0] * h + ag[1]; }
            cin[tid] = h; }
        __syncthreads();
        {
            float h = cin[c];
            for (int s2 = 0; s2 < seg; ++s2) h = segA[s2 * 64 + c] * h + segH[s2 * 64 + c];
#pragma unroll 4
            for (int i = 0; i < 16; ++i) { const int t = seg * 16 + i; h = ab[t * 64 + c] * h + xc[t * LR_XCS + c]; ab[t * 64 + c] = h; }
        }
        __syncthreads();
        for (int i = tid; i < 128 * 8; i += 512) {
            const int row = i >> 3, c8 = i & 7;
            const size_t go = (size_t)(rowb + c0 + row) * 1024 + hb * 64 + c8 * 8;
            const u32x4 v = *(const u32x4*)(P.GG + go);
            const f32x4 h0 = *(const LAS f32x4*)(ab + row * 64 + c8 * 8), h1 = *(const LAS f32x4*)(ab + row * 64 + c8 * 8 + 4);
            u32x4 o;
            o.x = pk2(__builtin_bit_cast(float, v.x << 16) * h0[0], __builtin_bit_cast(float, v.x & 0xffff0000u) * h0[1]);
            o.y = pk2(__builtin_bit_cast(float, v.y << 16) * h0[2], __builtin_bit_cast(float, v.y & 0xffff0000u) * h0[3]);
            o.z = pk2(__builtin_bit_cast(float, v.z << 16) * h1[0], __builtin_bit_cast(float, v.z & 0xffff0000u) * h1[1]);
            o.w = pk2(__builtin_bit_cast(float, v.w << 16) * h1[2], __builtin_bit_cast(float, v.w & 0xffff0000u) * h1[3]);
            *(u32x4*)(P.GAo + go) = o;
        }
        __syncthreads();
    }
}
template <int PASS>
__device__ __forceinline__ void lru_phase(Frame& F, const LruPtrs& P) {
    const int nitems = P.nb * 256;
    for (int it = F.bid; it < nitems; it += F.G) { const int b = it >> 8, ch = (it >> 4) & 15, hb = it & 15; lru_item<PASS>(F, P, b, hb, ch); }
}

constexpr int LS_XS = 0, LS_XC = 33792, LS_A = LS_XC + 128 * LR_XCS * 4, LS_SEG = LS_A + 16384, LS_CARRY = LS_SEG + 4096, LS_END = LS_CARRY + 128;
static_assert(LS_END <= STAGE_BYTES, "lru-seq LDS map");
__device__ __forceinline__ void lru_seq_item(Frame& F, const LruPtrs& P, int b, int hb, int half) {
    LAS unsigned char* lds = F.lds;
    int tid = threadIdx.x; asm volatile("" : "+v"(tid));
    const int lane = tid & 63, w = __builtin_amdgcn_readfirstlane(tid >> 6);
    LAS float* xs = (LAS float*)(lds + LS_XS); LAS float* xc = (LAS float*)(lds + LS_XC); LAS float* ab = (LAS float*)(lds + LS_A);
    LAS float* segA = (LAS float*)(lds + LS_SEG); LAS float* segH = segA + 512; LAS float* carry = (LAS float*)(lds + LS_CARRY);
    const long rowb = (long)b * S;
    const int fr = lane & 15, fq = lane >> 4;
    float bav[2], biv[2], spl[2]; bf16x8 waf[2][2], wif[2][2];
#pragma unroll
    for (int nt = 0; nt < 2; ++nt) { const int cl = half * 32 + nt * 16 + fr, cg = hb * 64 + cl;
        bav[nt] = P.ba[cg]; biv[nt] = P.bi[cg]; const float nl = -P.lam[cg]; spl[nt] = -8.0f * (fmaxf(nl, 0.f) + log1pf(expf(-fabsf(nl))));
#pragma unroll
        for (int kk = 0; kk < 2; ++kk) { const size_t wo = ((size_t)(hb * 64 + cl)) * 64 + kk * 32 + 8 * fq; waf[nt][kk] = *(const bf16x8*)(P.WaT + wo); wif[nt][kk] = *(const bf16x8*)(P.WiT + wo); } }
    const int cc = tid & 63, cgc = hb * 64 + cc;
    const float w0 = P.cw[cgc], w1 = P.cw[1024 + cgc], w2 = P.cw[2048 + cgc], w3 = P.cw[3072 + cgc], bb = P.cb[cgc];
    if (tid < 32) carry[tid] = 0.f;
    u32x4 pre[3];
#pragma unroll
    for (int j = 0; j < 3; ++j) { const int i = tid + 512 * j; pre[j] = (u32x4){0u, 0u, 0u, 0u};
        if (i < 131 * 8) { const int row = i >> 3, c8 = i & 7, t = row - 3; if (t >= 0) pre[j] = *(const u32x4*)(P.XR + (rowb + t) * 1024 + hb * 64 + c8 * 8); } }
    for (int ch = 0; ch < 16; ++ch) {
        const int c0 = ch * 128;
#pragma unroll
        for (int j = 0; j < 3; ++j) { const int i = tid + 512 * j;
            if (i < 131 * 8) { const int row = i >> 3, c8 = i & 7; const u32x4 v = pre[j]; f32x4 lo, hi4;
                lo[0] = __builtin_bit_cast(float, v.x << 16); lo[1] = __builtin_bit_cast(float, v.x & 0xffff0000u); lo[2] = __builtin_bit_cast(float, v.y << 16); lo[3] = __builtin_bit_cast(float, v.y & 0xffff0000u);
                hi4[0] = __builtin_bit_cast(float, v.z << 16); hi4[1] = __builtin_bit_cast(float, v.z & 0xffff0000u); hi4[2] = __builtin_bit_cast(float, v.w << 16); hi4[3] = __builtin_bit_cast(float, v.w & 0xffff0000u);
                *(LAS f32x4*)(xs + row * 64 + c8 * 8) = lo; *(LAS f32x4*)(xs + row * 64 + c8 * 8 + 4) = hi4; } }
        __syncthreads();
        const size_t go = (size_t)(rowb + c0 + (tid >> 2)) * 1024 + hb * 64 + half * 32 + (tid & 3) * 8;
        const u32x4 ggv = *(const u32x4*)(P.GG + go);
        if (ch + 1 < 16) {
#pragma unroll
            for (int j = 0; j < 3; ++j) { const int i = tid + 512 * j;
                if (i < 131 * 8) { const int row = i >> 3, c8 = i & 7; pre[j] = *(const u32x4*)(P.XR + (rowb + c0 + 128 - 3 + row) * 1024 + hb * 64 + c8 * 8); } }
        }
#pragma unroll 4
        for (int i = 0; i < 16; ++i) { const int t = (tid >> 6) + 8 * i;
            xc[t * LR_XCS + cc] = bb + w0 * xs[t * 64 + cc] + w1 * xs[(t + 1) * 64 + cc] + w2 * xs[(t + 2) * 64 + cc] + w3 * xs[(t + 3) * 64 + cc]; }
        __syncthreads();
        {
            bf16x8 af[2];
#pragma unroll
            for (int kk = 0; kk < 2; ++kk) { const LAS float* xp = xc + (16 * w + fr) * LR_XCS + kk * 32 + 8 * fq; const f32x4 x0 = *(const LAS f32x4*)xp, x1 = *(const LAS f32x4*)(xp + 4);
                u32x4 pk; pk.x = pk2(x0[0], x0[1]); pk.y = pk2(x0[2], x0[3]); pk.z = pk2(x1[0], x1[1]); pk.w = pk2(x1[2], x1[3]); af[kk] = __builtin_bit_cast(bf16x8, pk); }
            f32x4 R[2], I[2];
#pragma unroll
            for (int nt = 0; nt < 2; ++nt) { R[nt] = (f32x4){0.f, 0.f, 0.f, 0.f}; I[nt] = (f32x4){0.f, 0.f, 0.f, 0.f};
#pragma unroll
                for (int kk = 0; kk < 2; ++kk) { R[nt] = __builtin_amdgcn_mfma_f32_16x16x32_bf16(af[kk], waf[nt][kk], R[nt], 0, 0, 0); I[nt] = __builtin_amdgcn_mfma_f32_16x16x32_bf16(af[kk], wif[nt][kk], I[nt], 0, 0, 0); } }
            float xv[2][4];
#pragma unroll
            for (int nt = 0; nt < 2; ++nt)
#pragma unroll
                for (int r = 0; r < 4; ++r) xv[nt][r] = xc[(16 * w + 4 * fq + r) * LR_XCS + half * 32 + nt * 16 + fr];
#pragma unroll
            for (int nt = 0; nt < 2; ++nt)
#pragma unroll
                for (int r = 0; r < 4; ++r) {
                    const int tl = 16 * w + 4 * fq + r, c32 = nt * 16 + fr;
                    const float rg = fast_sigmoid(R[nt][r] + bav[nt]), ig = fast_sigmoid(I[nt][r] + biv[nt]);
                    const float la2 = rg * spl[nt];
                    const float a = __builtin_amdgcn_exp2f(la2 * 1.4426950408889634f);
                    const float x2 = 2.0f * la2;
                    const float ser = -x2 * (1.0f + x2 * (0.5f + x2 * (0.16666667f + x2 * (0.041666668f + x2 * 0.0083333338f))));
                    const float om = (x2 > -0.25f) ? ser : (1.0f - a * a);
                    ab[tl * 32 + c32] = a; xc[tl * LR_XCS + c32] = __builtin_amdgcn_sqrtf(om) * (ig * xv[nt][r]);
                }
        }
        __syncthreads();
        const int c = tid & 31, seg = tid >> 5;
        {
            float A = 1.f, H = 0.f;
#pragma unroll
            for (int i = 0; i < 8; ++i) { const int t = seg * 8 + i; const float a = ab[t * 32 + c], u = xc[t * LR_XCS + c]; H = a * H + u; A *= a; }
            segA[seg * 32 + c] = A; segH[seg * 32 + c] = H;
        }
        __syncthreads();
        if (tid < 32) {
            float sa[16], sh[16];
#pragma unroll
            for (int s2 = 0; s2 < 16; ++s2) { sa[s2] = segA[s2 * 32 + tid]; sh[s2] = segH[s2 * 32 + tid]; }
            float h = carry[tid];
#pragma unroll
            for (int s2 = 0; s2 < 16; ++s2) { segH[s2 * 32 + tid] = h; h = sa[s2] * h + sh[s2]; }
            carry[tid] = h;
        }
        __syncthreads();
        {
            float h = segH[seg * 32 + c];
#pragma unroll
            for (int i = 0; i < 8; ++i) { const int t = seg * 8 + i; h = ab[t * 32 + c] * h + xc[t * LR_XCS + c]; ab[t * 32 + c] = h; }
        }
        __syncthreads();
        {
            const int row = tid >> 2, c8 = tid & 3;
            const u32x4 v = ggv;
            const f32x4 h0 = *(const LAS f32x4*)(ab + row * 32 + c8 * 8), h1 = *(const LAS f32x4*)(ab + row * 32 + c8 * 8 + 4);
            u32x4 o;
            o.x = pk2(__builtin_bit_cast(float, v.x << 16) * h0[0], __builtin_bit_cast(float, v.x & 0xffff0000u) * h0[1]);
            o.y = pk2(__builtin_bit_cast(float, v.y << 16) * h0[2], __builtin_bit_cast(float, v.y & 0xffff0000u) * h0[3]);
            o.z = pk2(__builtin_bit_cast(float, v.z << 16) * h1[0], __builtin_bit_cast(float, v.z & 0xffff0000u) * h1[1]);
            o.w = pk2(__builtin_bit_cast(float, v.w << 16) * h1[2], __builtin_bit_cast(float, v.w & 0xffff0000u) * h1[3]);
            *(u32x4*)(P.GAo + go) = o;
        }
    }
    __syncthreads();
}
constexpr int L2_XS = 0, L2_XSB = 131 * 128  , L2_XC = 2 * L2_XSB, L2_XCS = 144  , L2_A = L2_XC + 128 * L2_XCS, L2_CS = 132  ,
              L2_U = L2_A + 32 * L2_CS * 4, L2_HC = L2_U + 32 * L2_CS * 4, L2_HS = 129, L2_END = L2_HC + 32 * L2_HS * 4;
static_assert(L2_END <= LDS_BYTES - 4096, "lru LDS map");
template <int SH> __device__ __forceinline__ float row_shr(float v, float ident) {
    return __builtin_bit_cast(float, __builtin_amdgcn_update_dpp(__builtin_bit_cast(int, ident), __builtin_bit_cast(int, v), 0x110 | SH, 0xf, 0xf, false)); }
__device__ __forceinline__ void lru2_item(Frame& F, const LruPtrs& P, int b, int hb, int half) {
    LAS unsigned char* lds = F.lds;
    int tid = threadIdx.x; asm volatile("" : "+v"(tid));
    const int lane = tid & 63, w = __builtin_amdgcn_readfirstlane(tid >> 6);
    const long rowb = (long)b * S;
    const int fr = lane & 15, fq = lane >> 4;
    float bav[2], biv[2], spl[2]; bf16x8 waf[2][2], wif[2][2];
#pragma unroll
    for (int nt = 0; nt < 2; ++nt) { const int cl = half * 32 + nt * 16 + fr, cg = hb * 64 + cl;
        bav[nt] = P.ba[cg]; biv[nt] = P.bi[cg]; const float nl = -P.lam[cg]; spl[nt] = -8.0f * 1.4426950408889634f * (fmaxf(nl, 0.f) + log1pf(expf(-fabsf(nl))));
#pragma unroll
        for (int kk = 0; kk < 2; ++kk) { const size_t wo = ((size_t)(hb * 64 + cl)) * 64 + kk * 32 + 8 * fq; waf[nt][kk] = *(const bf16x8*)(P.WaT + wo); wif[nt][kk] = *(const bf16x8*)(P.WiT + wo); } }
    const int cp = tid & 31, tg = tid >> 5, cg0 = hb * 64 + 2 * cp;
    const f32x2 cw0 = {P.cw[cg0], P.cw[cg0 + 1]}, cw1 = {P.cw[1024 + cg0], P.cw[1024 + cg0 + 1]}, cw2 = {P.cw[2048 + cg0], P.cw[2048 + cg0 + 1]}, cw3 = {P.cw[3072 + cg0], P.cw[3072 + cg0 + 1]}, cbb = {P.cb[cg0], P.cb[cg0 + 1]};
    float carry = 0.f;
    const unsigned l0 = (unsigned)(size_t)lds;
#define LRU_DMA(k_) do { const int c0_ = (k_) * 128; const unsigned bo_ = l0 + L2_XS + ((k_) & 1) * L2_XSB; \
        const bf16_t* s_ = P.XR + (rowb + c0_ + (lane >> 3)) * 1024 + hb * 64 + (lane & 7) * 8; \
        glds16(s_ + (long)(8 * w) * 1024, (unsigned)__builtin_amdgcn_readfirstlane(bo_ + (3 + 8 * w) * 128)); \
        glds16(s_ + (long)(8 * w + 64) * 1024, (unsigned)__builtin_amdgcn_readfirstlane(bo_ + (3 + 8 * w + 64) * 128)); \
        if (w == 0 && (k_) > 0) { if (lane < 24) glds16(s_ - 3 * 1024, (unsigned)__builtin_amdgcn_readfirstlane(bo_)); } } while (0)
    if (tid < 96) ((LAS unsigned*)(lds + L2_XS))[tid] = 0u;
    LRU_DMA(0);
    for (int ch = 0; ch < 16; ++ch) {
        int lt = tid; asm volatile("" : "+v"(lt));
        const int c0 = ch * 128;
        asm volatile("s_waitcnt vmcnt(0) lgkmcnt(0)" ::: "memory"); __builtin_amdgcn_s_barrier(); asm volatile("" ::: "memory");
        if (ch + 1 < 16) LRU_DMA(ch + 1);
        const size_t go = (size_t)(rowb + c0 + (lt >> 2)) * 1024 + hb * 64 + half * 32 + (lt & 3) * 8;
        const u32x4 ggv = *(const u32x4*)(P.GG + go);
        {
            const LAS unsigned* xs = (const LAS unsigned*)(lds + L2_XS + (ch & 1) * L2_XSB) + (8 * (lt >> 5)) * 32 + (lt & 31);
            LAS unsigned* xo = (LAS unsigned*)(lds + L2_XC) + (8 * (lt >> 5)) * (L2_XCS / 4) + (lt & 31);
            f32x2 x0, x1, x2;
            { const unsigned a0 = xs[0], a1 = xs[32], a2 = xs[64];
              x0 = (f32x2){__builtin_bit_cast(float, a0 << 16), __builtin_bit_cast(float, a0 & 0xffff0000u)}; x1 = (f32x2){__builtin_bit_cast(float, a1 << 16), __builtin_bit_cast(float, a1 & 0xffff0000u)};
              x2 = (f32x2){__builtin_bit_cast(float, a2 << 16), __builtin_bit_cast(float, a2 & 0xffff0000u)}; }
#pragma unroll
            for (int t = 0; t < 8; ++t) { const unsigned a3 = xs[(t + 3) * 32]; const f32x2 x3 = (f32x2){__builtin_bit_cast(float, a3 << 16), __builtin_bit_cast(float, a3 & 0xffff0000u)};
                const f32x2 o = cbb + cw0 * x0 + cw1 * x1 + cw2 * x2 + cw3 * x3;
                xo[t * (L2_XCS / 4)] = pk2(o.x, o.y); x0 = x1; x1 = x2; x2 = x3; }
        }
        asm volatile("s_waitcnt lgkmcnt(0)" ::: "memory"); __builtin_amdgcn_s_barrier(); asm volatile("" ::: "memory");
        {
            const int lw = __builtin_amdgcn_readfirstlane(lt >> 6), lfr = lt & 15, lfq = (lt & 63) >> 4;
            bf16x8 af[2];
#pragma unroll
            for (int kk = 0; kk < 2; ++kk) af[kk] = *(const LAS bf16x8*)(lds + L2_XC + (16 * lw + lfr) * L2_XCS + kk * 64 + lfq * 16);
            f32x4 R[2], I[2];
#pragma unroll
            for (int nt = 0; nt < 2; ++nt) { R[nt] = (f32x4){0.f, 0.f, 0.f, 0.f}; I[nt] = (f32x4){0.f, 0.f, 0.f, 0.f};
#pragma unroll
                for (int kk = 0; kk < 2; ++kk) { R[nt] = __builtin_amdgcn_mfma_f32_16x16x32_bf16(af[kk], waf[nt][kk], R[nt], 0, 0, 0); I[nt] = __builtin_amdgcn_mfma_f32_16x16x32_bf16(af[kk], wif[nt][kk], I[nt], 0, 0, 0); } }
            const LAS unsigned short* xh = (const LAS unsigned short*)(lds + L2_XC);
#pragma unroll
            for (int nt = 0; nt < 2; ++nt) {
                f32x4 av, uv;
#pragma unroll
                for (int r = 0; r < 4; ++r) {
                    const float xv = bf2f(xh[(16 * lw + 4 * lfq + r) * (L2_XCS / 2) + half * 32 + nt * 16 + lfr]);
                    const float rg = fast_sigmoid(R[nt][r] + bav[nt]), ig = fast_sigmoid(I[nt][r] + biv[nt]);
                    const float a = __builtin_amdgcn_exp2f(rg * spl[nt]);
                    const float om = __builtin_fmaf(-a, a, 1.0f);
                    av[r] = a; uv[r] = __builtin_amdgcn_sqrtf(om) * (ig * xv);
                }
                *(LAS f32x4*)(lds + L2_A + ((nt * 16 + lfr) * L2_CS + 16 * lw + 4 * lfq) * 4) = av;
                *(LAS f32x4*)(lds + L2_U + ((nt * 16 + lfr) * L2_CS + 16 * lw + 4 * lfq) * 4) = uv;
            }
        }
        asm volatile("s_waitcnt lgkmcnt(0)" ::: "memory"); __builtin_amdgcn_s_barrier(); asm volatile("" ::: "memory");
        {
            const int lw = __builtin_amdgcn_readfirstlane(lt >> 6), sc = 4 * lw + ((lt & 63) >> 4), seg = lt & 15;
            const LAS float* ap = (const LAS float*)(lds + L2_A) + sc * L2_CS + seg * 8; const LAS float* up = (const LAS float*)(lds + L2_U) + sc * L2_CS + seg * 8;
            const f32x4 a0 = *(const LAS f32x4*)ap, a1 = *(const LAS f32x4*)(ap + 4), u0 = *(const LAS f32x4*)up, u1 = *(const LAS f32x4*)(up + 4);
            float A = a0[0], H = u0[0];
#pragma unroll
            for (int i = 1; i < 4; ++i) { H = a0[i] * H + u0[i]; A *= a0[i]; }
#pragma unroll
            for (int i = 0; i < 4; ++i) { H = a1[i] * H + u1[i]; A *= a1[i]; }
            { const float Ap = row_shr<1>(A, 1.f), Hp = row_shr<1>(H, 0.f); H = A * Hp + H; A = A * Ap; }
            { const float Ap = row_shr<2>(A, 1.f), Hp = row_shr<2>(H, 0.f); H = A * Hp + H; A = A * Ap; }
            { const float Ap = row_shr<4>(A, 1.f), Hp = row_shr<4>(H, 0.f); H = A * Hp + H; A = A * Ap; }
            { const float Ap = row_shr<8>(A, 1.f), Hp = row_shr<8>(H, 0.f); H = A * Hp + H; A = A * Ap; }
            const float Ae = row_shr<1>(A, 1.f), He = row_shr<1>(H, 0.f);
            float h = Ae * carry + He;
            const float tot = A * carry + H;
            carry = __builtin_bit_cast(float, __builtin_amdgcn_ds_bpermute(((lt & 63) | 15) << 2, __builtin_bit_cast(int, tot)));
            LAS float* hp = (LAS float*)(lds + L2_HC) + sc * L2_HS + seg * 8;
#pragma unroll
            for (int i = 0; i < 4; ++i) { h = a0[i] * h + u0[i]; hp[i] = h; }
#pragma unroll
            for (int i = 0; i < 4; ++i) { h = a1[i] * h + u1[i]; hp[4 + i] = h; }
        }
        asm volatile("s_waitcnt lgkmcnt(0)" ::: "memory"); __builtin_amdgcn_s_barrier(); asm volatile("" ::: "memory");
        {
            const LAS float* hp = (const LAS float*)(lds + L2_HC) + ((lt & 3) * 8) * L2_HS + (lt >> 2);
            const u32x4 v = ggv;
            u32x4 o;
            o.x = pk2(__builtin_bit_cast(float, v.x << 16) * hp[0 * L2_HS], __builtin_bit_cast(float, v.x & 0xffff0000u) * hp[1 * L2_HS]);
            o.y = pk2(__builtin_bit_cast(float, v.y << 16) * hp[2 * L2_HS], __builtin_bit_cast(float, v.y & 0xffff0000u) * hp[3 * L2_HS]);
            o.z = pk2(__builtin_bit_cast(float, v.z << 16) * hp[4 * L2_HS], __builtin_bit_cast(float, v.z & 0xffff0000u) * hp[5 * L2_HS]);
            o.w = pk2(__builtin_bit_cast(float, v.w << 16) * hp[6 * L2_HS], __builtin_bit_cast(float, v.w & 0xffff0000u) * hp[7 * L2_HS]);
            if (P.ready) store16_wt(P.GAo + go, o); else *(u32x4*)(P.GAo + go) = o;
        }
    }
#undef LRU_DMA
    asm volatile("s_waitcnt vmcnt(0)" ::: "memory");
    __syncthreads();
    if (P.ready && tid == 0) __hip_atomic_fetch_add(P.ready + 4 * b, 1u, __ATOMIC_RELAXED, __HIP_MEMORY_SCOPE_AGENT);
}
__device__ __forceinline__ void lru_seq_phase(Frame& F, const LruPtrs& P) {
    for (int wi = F.bid; wi < P.nb * 32; wi += F.G) lru2_item(F, P, wi >> 5, (wi >> 1) & 15, wi & 1);
}

struct CmpPtrs { const bf16_t *KC, *VC; const bf16_t *W1Tk, *W1Tv, *W2Tk, *W2Tv; const float *b1k, *b1v, *b1part, *b2k, *b2v; const float* CS; bf16_t *KCMP, *VCMP; int nb; unsigned* ready; };
constexpr int CM_TILE = 0, CM_H = 528 * 128, CM_HS = 528  , CM_END = CM_H + 32 * CM_HS;
static_assert(CM_END <= STAGE_BYTES, "compress LDS map");
__device__ __forceinline__ float gelu_tanh_f(float x) { const float u = 0.7978845608028654f * (x + 0.044715f * x * x * x); return x * __builtin_amdgcn_rcpf(1.0f + __builtin_amdgcn_exp2f(-2.0f * 1.4426950408889634f * u)); }
__device__ __forceinline__ void cmp_item(Frame& F, const CmpPtrs& P, int b, int g, int kv, int mq) {
    LAS unsigned char* lds = F.lds;
    int tid = threadIdx.x; asm volatile("" : "+v"(tid));
    const int lane = tid & 63, w = __builtin_amdgcn_readfirstlane(tid >> 6), nl = lane & 31, hi = lane >> 5;
    const bf16_t* src = kv ? P.VC : P.KC; const bf16_t* W1T = kv ? P.W1Tv : P.W1Tk; const bf16_t* W2T = kv ? P.W2Tv : P.W2Tk;
    const int n0 = 32 * mq; const long rowb = (long)b * S;
    for (int i = tid; i < 528 * 8; i += 512) {
        const int row = i >> 3, ci = i & 7, tok = 16 * n0 + row;
        u32x4 v = (u32x4){0u, 0u, 0u, 0u};
        if (tok < S) v = *(const u32x4*)(src + (rowb + tok) * 256 + g * 64 + ci * 8);
        *(LAS u32x4*)(lds + CM_TILE + row * 128 + ((ci ^ ((row >> 4) & 7)) * 16)) = v;
    }
    __syncthreads();
    f32x16 acc;
#pragma unroll
    for (int r = 0; r < 16; ++r) acc[r] = 0.f;
    const bf16_t* wrow = W1T + (size_t)(32 * w + nl) * 2048 + 8 * hi;
    bf16x8 bA[8], bB[8];
#pragma unroll
    for (int i = 0; i < 8; ++i) bA[i] = *(const bf16x8*)(wrow + 16 * i);
#define CM_STEP(BW, ks_) do { const int ks = (ks_), j = ks >> 2, row = 16 * nl + j, ci = 2 * (ks & 3) + hi; \
        const bf16x8 a = *(const LAS bf16x8*)(lds + CM_TILE + row * 128 + ((ci ^ ((row >> 4) & 7)) * 16)); acc = __builtin_amdgcn_mfma_f32_32x32x16_bf16(a, BW, acc, 0, 0, 0); } while (0)
#pragma unroll 1
    for (int kb = 0; kb < 128; kb += 16) {
#pragma unroll
        for (int i = 0; i < 8; ++i) bB[i] = *(const bf16x8*)(wrow + 16 * (kb + 8 + i));
#pragma unroll
        for (int i = 0; i < 8; ++i) CM_STEP(bA[i], kb + i);
        if (kb + 16 < 128) {
#pragma unroll
            for (int i = 0; i < 8; ++i) bA[i] = *(const bf16x8*)(wrow + 16 * (kb + 16 + i));
        }
#pragma unroll
        for (int i = 0; i < 8; ++i) CM_STEP(bB[i], kb + 8 + i);
    }
#undef CM_STEP
    {
        const int c = 32 * w + nl;
        float bias = (kv ? P.b1v : P.b1k)[c];
#pragma unroll
        for (int sl = 0; sl < 16; ++sl) bias += P.b1part[(kv * 16 + sl) * 256 + c];
#pragma unroll
        for (int r = 0; r < 16; ++r) { const int n = (r & 3) + 8 * (r >> 2) + 4 * hi;
            *(LAS bf16_t*)(lds + CM_H + n * CM_HS + c * 2) = (bf16_t)f2bf(gelu_tanh_f(acc[r] + bias)); }
    }
    __syncthreads();
    if (w == 0) {
        f32x16 a0, a1;
#pragma unroll
        for (int r = 0; r < 16; ++r) { a0[r] = 0.f; a1[r] = 0.f; }
#pragma unroll 4
        for (int ks = 0; ks < 16; ++ks) {
            const bf16x8 a = *(const LAS bf16x8*)(lds + CM_H + nl * CM_HS + (16 * ks + 8 * hi) * 2);
            const bf16x8 b0 = *(const bf16x8*)(W2T + (size_t)nl * 256 + 16 * ks + 8 * hi), b1 = *(const bf16x8*)(W2T + (size_t)(nl + 32) * 256 + 16 * ks + 8 * hi);
            a0 = __builtin_amdgcn_mfma_f32_32x32x16_bf16(a, b0, a0, 0, 0, 0);
            a1 = __builtin_amdgcn_mfma_f32_32x32x16_bf16(a, b1, a1, 0, 0, 0);
        }
        const float* b2 = kv ? P.b2v : P.b2k; const float bb0 = b2[nl], bb1 = b2[nl + 32];
#pragma unroll
        for (int r = 0; r < 16; ++r) {
            const int n = n0 + (r & 3) + 8 * (r >> 2) + 4 * hi;
            float x1 = a0[r] + bb0, x2 = a1[r] + bb1;
            if (n >= 127) { x1 = 0.f; x2 = 0.f; }
            if (kv == 0) {
                const int pos = n < 127 ? 16 * n + 31 : 0; const f32x2 cs = *(const f32x2*)(P.CS + ((size_t)pos * 32 + nl) * 2);
                const float y1 = x1 * cs.x - x2 * cs.y, y2 = x2 * cs.x + x1 * cs.y;
                __hip_atomic_store((unsigned*)(P.KCMP + ((size_t)(b * 128 + n) * 256 + g * 64 + 2 * nl)), pk2(y1, y2), __ATOMIC_RELAXED, __HIP_MEMORY_SCOPE_AGENT);
            } else {
                bf16_t* vp = P.VCMP + ((size_t)(b * 128 + n) * 256 + g * 64);
                __hip_atomic_store(vp + nl, (bf16_t)f2bf(x1), __ATOMIC_RELAXED, __HIP_MEMORY_SCOPE_AGENT); __hip_atomic_store(vp + nl + 32, (bf16_t)f2bf(x2), __ATOMIC_RELAXED, __HIP_MEMORY_SCOPE_AGENT);
            }
        }
        if (P.ready) { asm volatile("s_waitcnt vmcnt(0)" ::: "memory"); if (lane == 0) __hip_atomic_fetch_add(P.ready + 8 * (b * 4 + g), 1u, __ATOMIC_RELAXED, __HIP_MEMORY_SCOPE_AGENT); }
    }
    __syncthreads();
}
__device__ __forceinline__ void cmp_phase(Frame& F, const CmpPtrs& P) {
    const int nitems = P.nb * 32;
    for (int it = F.bid; it < nitems; it += F.G) { const int b = it >> 5, g = (it >> 3) & 3, kv = (it >> 2) & 1, mq = it & 3; cmp_item(F, P, b, g, kv, mq); }
}

constexpr float QSCALE = 0.125f * 1.4426950408889634f;
constexpr int NPROJ = 6912;
__device__ __forceinline__ int win_src_col(int j) {
    if (j < 2048) return j;
    if (j < 3072) { const int c = j - 2048, hh = c >> 6, p = c & 63; return 2048 + hh * 64 + (p >> 1) + 32 * (p & 1); }
    if (j < 4608) { const int c = j - 3072, sec = c >> 8, cc = c & 255, g = cc >> 6, p = cc & 63; const int d = (sec == 2 || sec == 4) ? ((p >> 1) + 32 * (p & 1)) : p; return 3072 + sec * 256 + g * 64 + d; }
    if (j < 6656) return 4656 + (j - 4608);
    if (j < 6704) return 4608 + (j - 6656);
    return -1;
}
struct SrcWin { const float* w;
    __device__ __forceinline__ const float* ptr(int k, int n0, int q) const {
        int base;
        if (n0 < 4608) base = n0; else if (n0 < 6656) base = n0 + 48; else if (n0 == 6656 && q < 12) base = 4608; else return nullptr;
        return w + (size_t)k * 6704 + base + 4 * q; }
    __device__ __forceinline__ int dst(int n0, int q, int e) const {
        const int sec = (n0 - 3072) >> 8; const bool perm = (n0 >= 2048 && n0 < 3072) || (n0 >= 3072 && n0 < 4608 && (sec == 2 || sec == 4));
        const int d = 4 * q + e; return perm ? 2 * (d & 31) + (d >> 5) : d; } };
__device__ __forceinline__ void store8(bf16_t* dst, const f32x4& v0, const f32x4& v1) {
    u32x4 o; o.x = pk2(v0[0], v0[1]); o.y = pk2(v0[2], v0[3]); o.z = pk2(v1[0], v1[1]); o.w = pk2(v1[2], v1[3]); *(u32x4*)dst = o;
}
struct EpiProj {
    static constexpr bool PERM = true;
    unsigned char* ws; const float* CS;
    __device__ __forceinline__ void operator()(const f32x4 (&acc)[2][2][4][2], const Unit& u, int wr, int wc, int fr, int fq) const {
        const int pn = u.pn; const int row0 = u.pm * BM + wr * 64 + fr, cl0 = wc * 32 + 8 * fq;
#pragma unroll
        for (int ai = 0; ai < 2; ++ai)
#pragma unroll
            for (int m = 0; m < 4; ++m) { const size_t r = (size_t)(row0 + ai * HALF + m * 16);
#pragma unroll
                for (int bj = 0; bj < 2; ++bj) {
                    const int cl = cl0 + bj * HALF; f32x4 v0 = acc[ai][bj][m][0], v1 = acc[ai][bj][m][1];
                    if (pn < 4) { store8((bf16_t*)(ws + WS_XR) + r * 1024 + pn * 256 + cl, v0, v1); }
                    else if (pn < 8) {
#pragma unroll
                        for (int j = 0; j < 4; ++j) { v0[j] = gelu_tanh_f(v0[j]); v1[j] = gelu_tanh_f(v1[j]); }
                        store8((bf16_t*)(ws + WS_GG) + r * 1024 + (pn - 4) * 256 + cl, v0, v1); }
                    else if (pn < 12 || pn == 14 || pn == 16) {
                        const int pos = (int)(r & 2047), i0 = (cl & 63) >> 1;
                        const f32x4 c01 = *(const f32x4*)(CS + ((size_t)pos * 32 + i0) * 2), c23 = *(const f32x4*)(CS + ((size_t)pos * 32 + i0) * 2 + 4);
                        const float sc = pn < 12 ? QSCALE : 1.0f;
                        f32x4 y0, y1;
                        y0[0] = (v0[0] * c01[0] - v0[1] * c01[1]) * sc; y0[1] = (v0[1] * c01[0] + v0[0] * c01[1]) * sc;
                        y0[2] = (v0[2] * c01[2] - v0[3] * c01[3]) * sc; y0[3] = (v0[3] * c01[2] + v0[2] * c01[3]) * sc;
                        y1[0] = (v1[0] * c23[0] - v1[1] * c23[1]) * sc; y1[1] = (v1[1] * c23[0] + v1[0] * c23[1]) * sc;
                        y1[2] = (v1[2] * c23[2] - v1[3] * c23[3]) * sc; y1[3] = (v1[3] * c23[2] + v1[2] * c23[3]) * sc;
                        bf16_t* dst = pn < 12 ? (bf16_t*)(ws + WS_Q) + r * 1024 + (pn - 8) * 256 + cl : (bf16_t*)(ws + WS_KV + (size_t)(pn - 12) * 8 * MiB) + r * 256 + cl;
                        store8(dst, y0, y1); }
                    else if (pn < 18) { store8((bf16_t*)(ws + WS_KV + (size_t)(pn - 12) * 8 * MiB) + r * 256 + cl, v0, v1); }
                    else if (pn < 26) {
#pragma unroll
                        for (int j = 0; j < 4; ++j) { v0[j] = fast_sigmoid(v0[j]); v1[j] = fast_sigmoid(v1[j]); }
                        store8((bf16_t*)(ws + WS_MG) + r * 2048 + (pn - 18) * 256 + cl, v0, v1); }
                    else if (cl < 48) {
#pragma unroll
                        for (int j = 0; j < 4; ++j) { v0[j] = fast_sigmoid(v0[j]); v1[j] = fast_sigmoid(v1[j]); }
                        float* dst = (float*)(ws + WS_NG) + r * 48 + cl; *(f32x4*)dst = v0; *(f32x4*)(dst + 4) = v1; }
                }
                asm volatile("" ::: "memory"); }
    }
};
__device__ __forceinline__ void proj_phase(Frame& F, const bf16_t* hN) {
    StaticOrder Sc; Sc.init(T, NPROJ, F.G, F.bid);
    EpiProj E{F.ws, (const float*)(F.ws + WS_CS)};
    DenseA AO{2048u};
    gemm_phase<EpiProj, StaticOrder, DenseA, true>(F.lds, hN, (const bf16_t*)(F.ws + WS_WINT), 1024, Sc, E, AO);
}

struct PairOrder {
    int nM, nN, nwg, G, c;
    __device__ __forceinline__ void init(int M, int N, int G_, int c_) { nM = M / BM; nN = N / BM; nwg = nM * nN; G = G_; c = c_; }
    __device__ __forceinline__ bool next(int i, Unit& u) const {
        const long L = (long)(i >> 1) * G + c; if (L >= nwg) return false;
        int wgid = (int)L; { const int q = nwg / 8, r = nwg % 8, xcd = wgid % 8, off = wgid / 8; wgid = (xcd < r ? xcd * (q + 1) : r * (q + 1) + (xcd - r) * q) + off; }
        const int nig = 8 * nN, gid = wgid / nig, fm = gid * 8, gsz = (nM - fm) < 8 ? (nM - fm) : 8;
        const int sec = i & 1;
        u.pm = fm + ((wgid % nig) % gsz) + sec * nM; u.pn = (wgid % nig) / gsz + sec * nN; u.e = sec; u.r0 = 0; return true;
    }
    unsigned* lrdy = nullptr; unsigned* ordy = nullptr;
    __device__ __forceinline__ void a_ready(const Unit& u) const {
        if (ordy == nullptr) return;
        if (threadIdx.x < 64) {
            const int pmp = u.pm - u.e * nM; const unsigned* p = u.e ? ordy + 4 * pmp : lrdy + 4 * (pmp >> 3); const unsigned need = u.e ? 16u : 32u;
            unsigned sp = 0;
            while ((unsigned)__builtin_amdgcn_readfirstlane(__hip_atomic_load(p, __ATOMIC_RELAXED, __HIP_MEMORY_SCOPE_AGENT)) < need) { __builtin_amdgcn_s_sleep(2); if (++sp > (1u << 22)) break; }
            __builtin_amdgcn_fence(__ATOMIC_ACQUIRE, "agent");
            asm volatile("s_waitcnt vmcnt(0)" ::: "memory");
        }
        asm volatile("" ::: "memory"); __builtin_amdgcn_s_barrier(); asm volatile("" ::: "memory");
    }
};
struct EpiYab {
    static constexpr bool PERM = true;
    const bf16_t* MG; bf16_t* Mo; int nM, nN;
    __device__ __forceinline__ void operator()(const f32x4 (&acc)[2][2][4][2], const Unit& u, int wr, int wc, int fr, int fq) const {
        const int sec = u.e; const int row0 = (u.pm - sec * nM) * BM + wr * 64 + fr; const int col0 = (u.pn - sec * nN) * BM + wc * 32 + 8 * fq;
#pragma unroll
        for (int ai = 0; ai < 2; ++ai)
#pragma unroll
            for (int m = 0; m < 4; ++m) { const size_t r = (size_t)(row0 + ai * HALF + m * 16);
#pragma unroll
                for (int bj = 0; bj < 2; ++bj) {
                    const int c = col0 + bj * HALF;
                    const u32x4 gv = *(const u32x4*)(MG + r * 2048 + sec * 1024 + c);
                    f32x4 v0 = acc[ai][bj][m][0], v1 = acc[ai][bj][m][1];
                    v0[0] *= __builtin_bit_cast(float, gv.x << 16); v0[1] *= __builtin_bit_cast(float, gv.x & 0xffff0000u);
                    v0[2] *= __builtin_bit_cast(float, gv.y << 16); v0[3] *= __builtin_bit_cast(float, gv.y & 0xffff0000u);
                    v1[0] *= __builtin_bit_cast(float, gv.z << 16); v1[1] *= __builtin_bit_cast(float, gv.z & 0xffff0000u);
                    v1[2] *= __builtin_bit_cast(float, gv.w << 16); v1[3] *= __builtin_bit_cast(float, gv.w & 0xffff0000u);
                    bf16_t* dst = Mo + r * 1024 + c;
                    if (sec) {
                        const u32x4 pv = *(const u32x4*)dst;
                        v0[0] += __builtin_bit_cast(float, pv.x << 16); v0[1] += __builtin_bit_cast(float, pv.x & 0xffff0000u);
                        v0[2] += __builtin_bit_cast(float, pv.y << 16); v0[3] += __builtin_bit_cast(float, pv.y & 0xffff0000u);
                        v1[0] += __builtin_bit_cast(float, pv.z << 16); v1[1] += __builtin_bit_cast(float, pv.z & 0xffff0000u);
                        v1[2] += __builtin_bit_cast(float, pv.w << 16); v1[3] += __builtin_bit_cast(float, pv.w & 0xffff0000u);
                    }
                    u32x4 o; o.x = pk2(v0[0], v0[1]); o.y = pk2(v0[2], v0[3]); o.z = pk2(v1[0], v1[1]); o.w = pk2(v1[2], v1[3]);
                    *(u32x4*)dst = o;
                }
                if (m == 3) asm volatile("" ::: "memory"); }
    }
};
__device__ __forceinline__ void yab_phase(Frame& F, const bf16_t* A2, const bf16_t* WrnT, const bf16_t* MG, bf16_t* Mo, int Mr, unsigned* ordy, unsigned* lrdy) {
    PairOrder Sc; Sc.init(Mr, 1024, F.G, F.bid); Sc.ordy = ordy; Sc.lrdy = lrdy;
    EpiYab E{MG, Mo, Mr / BM, 4};
    DenseA AO{2048u};
    gemm_phase<EpiYab, PairOrder, DenseA, true>(F.lds, A2, WrnT, 1024, Sc, E, AO);
}
struct EpiMix {
    static constexpr bool PERM = true;
    const float* x; bf16_t* x1; unsigned* ready;
    __device__ __forceinline__ void operator()(const f32x4 (&acc)[2][2][4][2], const Unit& u, int wr, int wc, int fr, int fq) const {
        const int row0 = u.pm * BM + wr * 64 + fr, col0 = u.pn * BM + wc * 32 + 8 * fq;
#pragma unroll
        for (int ai = 0; ai < 2; ++ai)
#pragma unroll
            for (int m = 0; m < 4; ++m) { const size_t off = (size_t)(row0 + ai * HALF + m * 16) * D + col0;
#pragma unroll
                for (int bj = 0; bj < 2; ++bj) { const f32x4 xa = *(const f32x4*)(x + off + bj * HALF), xb = *(const f32x4*)(x + off + bj * HALF + 4);
                    const f32x4 v0 = xa + acc[ai][bj][m][0], v1 = xb + acc[ai][bj][m][1];
                    u32x4 o; o.x = pk2(v0[0], v0[1]); o.y = pk2(v0[2], v0[3]); o.z = pk2(v1[0], v1[1]); o.w = pk2(v1[2], v1[3]);
                    if (ready) store16_wt(x1 + off + bj * HALF, o); else *(u32x4*)(x1 + off + bj * HALF) = o; } }
        if (ready) {
            asm volatile("s_waitcnt vmcnt(0)" ::: "memory");
            if ((threadIdx.x & 63) == 0) __hip_atomic_fetch_add(ready + 16 * u.pm, 1u, __ATOMIC_RELAXED, __HIP_MEMORY_SCOPE_AGENT);
        }
    }
};
__device__ __forceinline__ void mixout_phase(Frame& F, const bf16_t* Mi, const bf16_t* WmT, const float* x, bf16_t* x1, int Mr, unsigned* ready) {
    StaticOrder Sc; Sc.init(Mr, 1024, F.G, F.bid);
    EpiMix E{x, x1, ready};
    DenseA AO{2048u};
    gemm_phase<EpiMix, StaticOrder, DenseA, true>(F.lds, Mi, WmT, 1024, Sc, E, AO);
}
__device__ __forceinline__ void pro_phase(Frame& F, bf16_t* hN) {
    LAS float* scr = (LAS float*)(F.lds + F.wave * CONV_SCR);
    const int gw = F.bid * 8 + F.wave, NGW = F.G * 8;
    constexpr int I_SQ = (1024 / 64) * (1024 / 64);
    bf16_t* WrnT = (bf16_t*)(F.ws + WS_WRNT); bf16_t* WmT = (bf16_t*)(F.ws + WS_WMT);
    if (F.bid == 0 && F.tid < 16) ((unsigned*)(F.ws + WS_GCNT))[F.tid] = 0u;
    {
        SrcWin sw{INP(2)}; bf16_t* WinT = (bf16_t*)(F.ws + WS_WINT);
#define MK_WIN(it, s, K, WT, nblk, r) do { s = sw; K = 1024; WT = WinT; nblk = NPROJ / 64; r = (it); } while (0)
        CONV_LOOP(SrcWin, gw, NGW, 16 * (NPROJ / 64), MK_WIN);
#undef MK_WIN
    }
    if (hN) {
        const float* x = INP(0); const float* g1 = INP(1);
        for (int t = gw; t < T; t += NGW) {
            const f32x4* xr = (const f32x4*)(x + (size_t)t * D) + F.lane; f32x4 v[4]; float ss = 0.f;
#pragma unroll
            for (int j = 0; j < 4; ++j) { v[j] = xr[64 * j]; ss += (v[j].x * v[j].x + v[j].y * v[j].y) + (v[j].z * v[j].z + v[j].w * v[j].w); }
            const float rinv = rsqrtf(wave_sum(ss) * (1.f / D) + 1e-6f);
            unsigned long long* o8 = (unsigned long long*)(hN + (size_t)t * D) + F.lane;
#pragma unroll
            for (int j = 0; j < 4; ++j) { const f32x4 gv = ((const f32x4*)g1)[F.lane + 64 * j]; const f32x4 h = v[j] * rinv * gv;
                o8[64 * j] = (unsigned long long)pk2(h.x, h.y) | ((unsigned long long)pk2(h.z, h.w) << 32); }
        }
    }
    for (int it = gw; it < 3 * I_SQ; it += NGW) {
        const int which = it / I_SQ, r = it % I_SQ;
        if (which == 0) { SrcPlain s{INP(10), 1024}; transpose_tile(s, 1024, WrnT, 16, scr, r, F.lane); }
        else if (which == 1) { SrcPlain s{INP(21), 1024}; transpose_tile(s, 1024, WrnT + (size_t)1024 * 1024, 16, scr, r, F.lane); }
        else { SrcPlain s{INP(22), 1024}; transpose_tile(s, 1024, WmT, 16, scr, r, F.lane); }
    }
    {
        bf16_t* W1Tk = (bf16_t*)(F.ws + WS_W1TK); bf16_t* W1Tv = (bf16_t*)(F.ws + WS_W1TV); bf16_t* W2Tk = (bf16_t*)(F.ws + WS_W2T); bf16_t* W2Tv = W2Tk + 64 * 256;
        constexpr int I1 = (2048 / 64) * (256 / 64), I2 = (256 / 64) * (64 / 64);
        for (int it = gw; it < 2 * (I1 + I2); it += NGW) { const int kv = it / (I1 + I2), r = it % (I1 + I2);
            if (r < I1) { SrcPlain s{kv ? INP(17) : INP(12), 256}; transpose_tile(s, 2048, kv ? W1Tv : W1Tk, 4, scr, r, F.lane); }
            else { SrcPlain s{kv ? INP(19) : INP(14), 64}; transpose_tile(s, 256, kv ? W2Tv : W2Tk, 1, scr, r - I1, F.lane); } }
    }
    {
        bf16_t* WRS = (bf16_t*)(F.ws + WS_WRS); const float* rgw = INP(24); const float* rew = INP(26);
        for (int e = F.bid * 512 + F.tid; e < 32 * 1024; e += F.G * 512) { const int n = e >> 10, kk = e & 1023;
            const float v = (n < 4) ? rgw[kk * 4 + n] : (n < 20) ? rew[((size_t)((n - 4) >> 2) * 1024 + kk) * 4 + ((n - 4) & 3)] : 0.f;
            const unsigned hb = f2bf(v); const float lo = v - __builtin_bit_cast(float, hb << 16);
            WRS[e] = (bf16_t)hb; WRS[32 * 1024 + e] = (bf16_t)f2bf(lo); }
    }
    {
        float* CS = (float*)(F.ws + WS_CS);
        for (int e = F.bid * 512 + F.tid; e < 2048 * 32; e += F.G * 512) { const int pos = e >> 5, i = e & 31;
            const float inv_freq = powf(10000.0f, -((float)(2 * i) / 64.0f)); const float ang = (float)pos * inv_freq;
            CS[2 * e] = cosf(ang); CS[2 * e + 1] = sinf(ang); }
    }
    {
        float* b1part = (float*)(F.ws + WS_MISC);
        for (int u = F.bid; u < 32; u += F.G) { const int kv = u >> 4, sl = u & 15; const float* pos = kv ? INP(16) : INP(11); const float* w1 = kv ? INP(17) : INP(12);
            if (F.tid < 256) { float acc = 0.f; for (int k = sl * 128; k < sl * 128 + 128; ++k) acc += pos[k] * w1[(size_t)k * 256 + F.tid]; b1part[(kv * 16 + sl) * 256 + F.tid] = acc; } }
    }
    {
        bf16_t* WaT = (bf16_t*)(F.ws + WS_WAIT); bf16_t* WiT = WaT + 16 * 64 * 64;
        for (int it = gw; it < 2 * 16; it += NGW) { const int which = it >> 4, hb = it & 15;
            SrcPlain s{(which ? INP(7) : INP(5)) + (size_t)hb * 64 * 64, 64};
            transpose_tile(s, 64, (which ? WiT : WaT) + (size_t)hb * 64 * 64, 1, scr, 0, F.lane); }
    }
}

enum { PH_PRO = 0, PH_PROJ, PH_MID, PH_MIX, PH_YAB, PH_MIXOUT, PH_ROUTE, PH_MOE1, PH_MOE2, PH_FINAL, PH_COUNT };

template <bool COOP>
__device__ __forceinline__ void mk_body(const Args& args, unsigned char* lds_raw) {
    if (threadIdx.x == 0) {
        LAS unsigned long long* pt = (LAS unsigned long long*)((LAS unsigned char*)lds_raw + PTAB_OFF);
#pragma unroll
        for (int k = 0; k < 32; ++k) pt[k] = (unsigned long long)args.in[k];
        pt[32] = (unsigned long long)args.out; pt[33] = (unsigned long long)args.ws;
        ((LAS unsigned*)((LAS unsigned char*)lds_raw + XBST_OFF))[0] = 0u; ((LAS unsigned*)((LAS unsigned char*)lds_raw + XBST_OFF))[1] = 0u;
    }
    __syncthreads();
    XcdBarrier bar; bar.bar = nullptr; bar.x = 0; bar.st = nullptr;
    if (COOP) bar = xcd_barrier_post((unsigned*)(args.ws + WS_BAR), (volatile LAS unsigned*)((LAS unsigned char*)lds_raw + XBST_OFF));
    const int lo = args.ph_lo, hi = args.ph_hi;
#define IN(k) (lo <= (k) && (k) < hi)
#define SEAM(k) do { if (COOP && IN(k) && IN((k) + 1)) { xcd_barrier(bar); } } while (0)
    constexpr int PRE_OFF = TAB_BASE;
#ifndef DUP_PH
#define DUP_PH (-1)
#define DUP_N 0
#endif
#define REPS(k) for (int rep = (COOP && DUP_PH == (k)) ? DUP_N : 0; rep >= 0; --rep)
#define REPSEAM() do { if (rep > 0) xcd_barrier(bar); } while (0)
    if (IN(PH_PRO)) REPS(PH_PRO) { Frame F = make_frame(lds_raw); pro_phase(F, (bf16_t*)P_OUT); REPSEAM(); }
    SEAM(PH_PRO);
    if (IN(PH_PROJ)) REPS(PH_PROJ) { Frame F = make_frame(lds_raw); proj_phase(F, (const bf16_t*)P_OUT);
        if (F.G == 256 && F.bid >= 192) { __syncthreads(); conv_w1e(F, INP(28), INP(29), (bf16_t*)((unsigned char*)P_OUT + OUT_W1E), 0, W1E_EARLY, (F.bid - 192) * 8 + F.wave, 512); }
        REPSEAM(); }
    SEAM(PH_PROJ);
    if (IN(PH_MID)) REPS(PH_MID) {
        { Frame F = make_frame(lds_raw);
          CmpPtrs CP{(const bf16_t*)(F.ws + WS_KV), (const bf16_t*)(F.ws + WS_KV + 8 * MiB), (const bf16_t*)(F.ws + WS_W1TK), (const bf16_t*)(F.ws + WS_W1TV), (const bf16_t*)(F.ws + WS_W2T), (const bf16_t*)(F.ws + WS_W2T) + 64 * 256,
                     INP(13), INP(18), (const float*)(F.ws + WS_MISC), INP(15), INP(20), (const float*)(F.ws + WS_CS), (bf16_t*)(F.ws + WS_KCMP), (bf16_t*)(F.ws + WS_VCMP), NB, (COOP && DUP_PH != PH_MID && DUP_PH != PH_MIX) ? (unsigned*)(F.ws + WS_RDY3) : nullptr};
          cmp_phase(F, CP); }
        { Frame F = make_frame(lds_raw);
          LruPtrs LP{(const bf16_t*)(F.ws + WS_XR), (const bf16_t*)(F.ws + WS_GG), rep > 0 ? (bf16_t*)P_OUT : (bf16_t*)(F.ws + WS_GG), INP(3), INP(4), INP(6), INP(8), INP(9), (const bf16_t*)(F.ws + WS_WAIT), (const bf16_t*)(F.ws + WS_WAIT) + 16 * 64 * 64, (float*)(F.ws + WS_AGG), NB, (COOP && DUP_PH < 0) ? (unsigned*)(F.ws + WS_RDY4 + 1024) : nullptr};
          lru_seq_phase(F, LP); }
        REPSEAM();
    }
    if (!(COOP && DUP_PH != PH_MID && DUP_PH != PH_MIX)) { SEAM(PH_MID); }
    if (IN(PH_MIX)) REPS(PH_MIX) {
        { Frame F = make_frame(lds_raw);
          AttnPtrs AP{(const bf16_t*)(F.ws + WS_Q), (const bf16_t*)(F.ws + WS_KV + 16 * MiB), (const bf16_t*)(F.ws + WS_KV + 24 * MiB), (const bf16_t*)(F.ws + WS_KV + 32 * MiB), (const bf16_t*)(F.ws + WS_KV + 40 * MiB),
                      (const bf16_t*)(F.ws + WS_KCMP), (const bf16_t*)(F.ws + WS_VCMP), (const float*)(F.ws + WS_NG), rep > 0 ? (bf16_t*)P_OUT : (bf16_t*)(F.ws + WS_Q), NB, (COOP && DUP_PH != PH_MID && DUP_PH != PH_MIX) ? (unsigned*)(F.ws + WS_RDY3) : nullptr, (COOP && DUP_PH < 0) ? (unsigned*)(F.ws + WS_RDY4) : nullptr};
#if defined(DUP_SKIP_ATTN)
          if (rep == 0)
#endif
#if defined(DUP_MODE)
          attn_phase(F, AP, rep > 0 ? DUP_MODE : 0); }
#else
          attn_phase(F, AP); }
#endif
        REPSEAM();
    }
    if (!(COOP && DUP_PH < 0)) { SEAM(PH_MIX); }
    if (IN(PH_YAB)) REPS(PH_YAB) { Frame F = make_frame(lds_raw); yab_phase(F, (const bf16_t*)(F.ws + WS_GG), (const bf16_t*)(F.ws + WS_WRNT), (const bf16_t*)(F.ws + WS_MG), (bf16_t*)(F.ws + WS_M), T, (COOP && DUP_PH < 0) ? (unsigned*)(F.ws + WS_RDY4) : nullptr, (COOP && DUP_PH < 0) ? (unsigned*)(F.ws + WS_RDY4 + 1024) : nullptr); REPSEAM(); }
    SEAM(PH_YAB);
    if (IN(PH_MIXOUT)) REPS(PH_MIXOUT) { Frame F = make_frame(lds_raw); mixout_phase(F, (const bf16_t*)(F.ws + WS_M), (const bf16_t*)(F.ws + WS_WMT), INP(0), (bf16_t*)(F.ws + WS_X1B), T, (COOP && DUP_PH != PH_MIXOUT && DUP_PH != PH_ROUTE) ? (unsigned*)(F.ws + WS_RDY2) : nullptr); REPSEAM(); }
    if (!(COOP && DUP_PH != PH_MIXOUT && DUP_PH != PH_ROUTE)) { SEAM(PH_MIXOUT); }
    if (IN(PH_ROUTE)) REPS(PH_ROUTE) { Frame F = make_frame(lds_raw);
        route_phase(F, (const bf16_t*)(F.ws + WS_X1B), INP(23), INP(24), INP(25), INP(26), INP(27), INP(28), INP(29), INP(30), (bf16_t*)((unsigned char*)P_OUT + OUT_W1E), (COOP && DUP_PH != PH_MIXOUT && DUP_PH != PH_ROUTE) ? (unsigned*)(F.ws + WS_RDY2) : nullptr);
        if (rep > 0) { xcd_barrier(bar); if (F.bid == 0 && F.tid < 16) ((unsigned*)(F.ws + WS_GCNT))[F.tid] = 0u; xcd_barrier(bar); }
    }
    SEAM(PH_ROUTE);
    if (IN(PH_MOE1)) REPS(PH_MOE1) { Frame F = make_frame(lds_raw);
        moe_prefix(F, (LAS int*)(F.lds + PRE_OFF));
        MoeSched Sc{(const LAS int*)(F.lds + PRE_OFF), F.G, F.bid, 4, 0, nullptr};
        GatherA AO{(const unsigned*)(F.ws + WS_LIST), (const unsigned*)(F.ws + WS_GCNT)};
        EpiMoe1 E{(bf16_t*)(F.ws + WS_ACT), (unsigned*)(F.ws + WS_RDY)};
        gemm_phase<EpiMoe1, MoeSched, GatherA, true>(F.lds, (const bf16_t*)(F.ws + WS_H2), (const bf16_t*)((const unsigned char*)P_OUT + OUT_W1E), 1024, Sc, E, AO);
        REPSEAM();
    }
    if (!COOP) { SEAM(PH_MOE1); }
    if (IN(PH_MOE2)) REPS(PH_MOE2) { Frame F = make_frame(lds_raw);
        moe_prefix(F, (LAS int*)(F.lds + PRE_OFF));
        MoeSched Sc{(const LAS int*)(F.lds + PRE_OFF), F.G, F.bid, 4, COOP ? 1 : 0, COOP ? (unsigned*)(F.ws + WS_RDY) : nullptr};
        DenseAct AO{1024u};
        EpiMoe2 E{(bf16_t*)(F.ws + WS_Y0), (bf16_t*)(F.ws + WS_Y1), (const unsigned*)(F.ws + WS_LIST), (const unsigned*)(F.ws + WS_GCNT), (const float*)(F.ws + WS_TOKW)};
        gemm_phase<EpiMoe2, MoeSched, DenseAct, true>(F.lds, (const bf16_t*)(F.ws + WS_ACT), (const bf16_t*)(F.ws + WS_WDT), 512, Sc, E, AO);
        REPSEAM();
    }
    SEAM(PH_MOE2);
    if (IN(PH_FINAL)) REPS(PH_FINAL) { Frame F = make_frame(lds_raw);
        final_phase(F, (const bf16_t*)(F.ws + WS_X1B), rep > 0 ? (float*)(F.ws + WS_KV) : P_OUT, INP(31));
        REPSEAM();
    }
#undef REPS
#undef REPSEAM
#undef IN
#undef SEAM
}
__global__ void __launch_bounds__(512, 2) mk_fwd(Args args) {
    extern __shared__ __attribute__((aligned(16))) unsigned char lds_raw[];
    mk_body<MK_COOP != 0>(args, lds_raw);
}
}

extern "C" void kernel_launch(void* const* d_in, const int* in_sizes, int n_in, void* d_out, int out_size, void* d_ws, size_t ws_size, hipStream_t stream) {
    if (n_in != 32 || ws_size < 256 * mk::MiB || out_size != mk::T * mk::D) { fprintf(stderr, "kernel_launch: unexpected problem (n_in %d, out %d, ws %zu)\n", n_in, out_size, ws_size); return; }
    static int grid = 0;
    if (grid == 0) {
        if (hipFuncSetAttribute((const void*)mk::mk_fwd, hipFuncAttributeMaxDynamicSharedMemorySize, mk::LDS_BYTES) != hipSuccess) { fprintf(stderr, "kernel_launch: hipFuncSetAttribute failed\n"); grid = -1; return; }
        int dev = 0, cus = 0, per_cu = 0;
        (void)hipGetDevice(&dev); (void)hipDeviceGetAttribute(&cus, hipDeviceAttributeMultiprocessorCount, dev);
        (void)hipOccupancyMaxActiveBlocksPerMultiprocessor(&per_cu, (const void*)mk::mk_fwd, 512, mk::LDS_BYTES);
        if (per_cu < 1 || cus < 256) { fprintf(stderr, "kernel_launch: occupancy %d blocks/CU, %d CUs\n", per_cu, cus); }
        grid = 256;
    }
    if (grid < 0) return;
    mk::Args a{};
    for (int i = 0; i < 32; ++i) a.in[i] = (const float*)d_in[i];
    a.out = (float*)d_out; a.ws = (unsigned char*)d_ws;
#if MK_COOP
    if (hipMemsetAsync((char*)d_ws, 0, 32 * 1024, stream) != hipSuccess) { fprintf(stderr, "kernel_launch: memset failed\n"); return; }
    a.ph_lo = 0; a.ph_hi = mk::PH_COUNT;
    void* kargs[] = {&a};
    const hipError_t e = hipLaunchCooperativeKernel((const void*)mk::mk_fwd, dim3(grid), dim3(512), kargs, mk::LDS_BYTES, stream);
    if (e != hipSuccess) fprintf(stderr, "kernel_launch: cooperative launch failed: %s\n", hipGetErrorString(e));
#else
    for (int ph = 0; ph < mk::PH_COUNT; ++ph) { a.ph_lo = ph; a.ph_hi = ph + 1; hipLaunchKernelGGL(mk::mk_fwd, dim3(grid), dim3(512), mk::LDS_BYTES, stream, a); }
#endif
}
```

```cpp
#include <hip/hip_runtime.h>
#include <hip/hip_cooperative_groups.h>
#include <cstdio>
#include <cstdint>
#include <cmath>
#ifndef MK_COOP
#define MK_COOP 1
#endif

#define LAS __attribute__((address_space(3)))
#define GAS __attribute__((address_space(1)))
namespace mk {
typedef unsigned short bf16_t;
typedef short bf16x8 __attribute__((ext_vector_type(8)));
typedef float f32x4 __attribute__((ext_vector_type(4)));
typedef float f32x2 __attribute__((ext_vector_type(2)));
typedef float f32x16 __attribute__((ext_vector_type(16)));
typedef unsigned u32x4 __attribute__((ext_vector_type(4)));
typedef unsigned u32x2 __attribute__((ext_vector_type(2)));

constexpr int T = 16384, S = 2048, NB = 8, D = 1024;
constexpr size_t MiB = 1u << 20;
constexpr size_t WS_GCNT = 0;
constexpr size_t WS_RDY3 = 1024;
constexpr size_t WS_RDY = 2 * 1024;
constexpr size_t WS_RDY2 = 12 * 1024;
constexpr size_t WS_BAR = 16 * 1024;
constexpr size_t WS_RDY4 = 30 * 1024 + 512;
constexpr size_t WS_TOKW = 64 * 1024;
constexpr size_t WS_LIST = 256 * 1024;
constexpr size_t WS_WSL = 244 * MiB;
constexpr size_t WS_AGG = 2 * MiB;
constexpr size_t WS_KCMP = 3 * MiB, WS_VCMP = 3 * MiB + 512 * 1024;
constexpr size_t WS_CS = 4 * MiB;
constexpr size_t WS_MISC = 4 * MiB + 512 * 1024;
constexpr size_t WS_WRS = 5 * MiB;
constexpr size_t WS_WRNT = 8 * MiB, WS_WMT = 12 * MiB, WS_W1TK = 14 * MiB, WS_W1TV = 15 * MiB, WS_W2T = 16 * MiB, WS_WAIT = 16 * MiB + 256 * 1024;
constexpr size_t WS_WINT = 18 * MiB;
constexpr size_t WS_XR = 32 * MiB, WS_GG = 64 * MiB, WS_Q = 96 * MiB, WS_KV = 128 * MiB, WS_MG = 176 * MiB, WS_NG = 240 * MiB;
constexpr size_t WS_M = WS_XR, WS_H2 = WS_GG, WS_WDT = 160 * MiB, WS_ACT = WS_MG, WS_Y0 = WS_Q, WS_Y1 = WS_XR;
constexpr int ACT_ROWS = 36864;
constexpr size_t WS_X1B = 212 * MiB;

constexpr int LDS_BYTES = 163840;

__device__ __forceinline__ unsigned f2bf(float f) { unsigned u = __builtin_bit_cast(unsigned, f); return (u + 0x7fffu + ((u >> 16) & 1u)) >> 16; }
typedef __bf16 bf16x2_hw __attribute__((ext_vector_type(2)));
__device__ __forceinline__ unsigned pk2(float lo, float hi) { const f32x2 v = {lo, hi}; const bf16x2_hw b = __builtin_convertvector(v, bf16x2_hw); return __builtin_bit_cast(unsigned, b); }
__device__ __forceinline__ void store16_wt(void* p, const u32x4& v) { asm volatile("global_store_dwordx4 %0, %1, off sc1\n\ts_nop 1" :: "v"(p), "v"(v) : "memory"); }
__device__ __forceinline__ float bf2f(unsigned short b) { return __builtin_bit_cast(float, (unsigned)b << 16); }
__device__ __forceinline__ float wave_sum(float v) {
#pragma unroll
    for (int o = 1; o < 64; o <<= 1) v += __shfl_xor(v, o);
    return v;
}
template <int CTRL, int ROWMASK> __device__ __forceinline__ float dpp_term(float v) { return __builtin_bit_cast(float, __builtin_amdgcn_update_dpp(0, __builtin_bit_cast(int, v), CTRL, ROWMASK, 0xf, false)); }
__device__ __forceinline__ float wave_sum_dpp(float v) {
    v += dpp_term<0xB1, 0xf>(v);
    v += dpp_term<0x4E, 0xf>(v);
    v += dpp_term<0x141, 0xf>(v);
    v += dpp_term<0x140, 0xf>(v);
    v += dpp_term<0x142, 0xa>(v);
    v += dpp_term<0x143, 0xc>(v);
    return __builtin_bit_cast(float, __builtin_amdgcn_readlane(__builtin_bit_cast(int, v), 63));
}

constexpr int BM = 256, BK = 64, HALF = 128, HTB = HALF * BK * 2, STAGE_BYTES = 8 * HTB;
constexpr int GOFF_OFF = STAGE_BYTES + 1024;
__device__ __forceinline__ int lds_byte(int r, int c) { const int st = (r >> 4) * 2 + (c >> 5), rr = r & 15, cc = c & 31, ob = rr * 64 + cc * 2; return st * 1024 + (ob ^ (((ob >> 9) & 1) << 5)); }
__device__ __forceinline__ void stage_rc(int b, int& R, int& C) { const int st = b / 1024, sb = b % 1024, swz = sb ^ (((sb >> 9) & 1) << 5); R = (st >> 1) * 16 + swz / 64; C = (st & 1) * 32 + (swz % 64) / 2; }
__device__ __forceinline__ int perm32(int rho) { const int n = rho >> 4, i = rho & 15; return 8 * (i >> 2) + 4 * n + (i & 3); }

struct Unit { int pm, pn, e, r0; };

template <class Epi, class Sched, class AOff, bool ALIGN_EPI>
__device__ __forceinline__ void gemm_phase(LAS unsigned char* lds, const bf16_t* Aptr, const bf16_t* Bt, const int K, const Sched& S, const Epi& E, const AOff& AO) {
    const int tid = threadIdx.x, wid = __builtin_amdgcn_readfirstlane(tid >> 6), lane = tid & 63, wr = wid >> 2, wc = wid & 3, fr = lane & 15, fq = lane >> 4;
    const int nt = K / BK;
    unsigned voffB[2];
#pragma unroll
    for (int i = 0; i < 2; ++i) { int R, C; stage_rc(tid * 16 + i * 8192, R, C); const int Rb = Epi::PERM ? ((R & ~31) + perm32(R & 31)) : R; voffB[i] = (unsigned)(Rb * K + C) * 2u; }
    const size_t kstep = (size_t)(BK * 2);
    const size_t hstep = (size_t)HALF * K * 2;
    const size_t tstep = 2 * hstep;
    const unsigned ldsw = (unsigned)wid * 1024u;
    const int aoff = lds_byte(wr * 64 + fr, fq * 8), boff = lds_byte(wc * 32 + fr, fq * 8);
    const char* const Abase = (const char*)Aptr;
#define PG8_SA(b, h) (((b) * 2 + (h)) * HTB)
#define PG8_SB(b, h) ((4 + (b) * 2 + (h)) * HTB)
#define PG8_STAGE(bufoff, gbase, voff) do { _Pragma("unroll") for (int _i = 0; _i < 2; ++_i) \
        __builtin_amdgcn_global_load_lds((const unsigned*)((const char*)(gbase) + (voff)[_i]), (LAS unsigned*)(lds + (bufoff) + ldsw + _i * 8192), 16, 0, 0); } while (0)
#define PG8_LDA(dst, b, h) do { _Pragma("unroll") for (int m = 0; m < 4; ++m) _Pragma("unroll") for (int k = 0; k < 2; ++k) dst[m][k] = *(const LAS bf16x8*)(lds + PG8_SA(b, h) + aoff + m * 2048 + k * 1024); } while (0)
#define PG8_LDB(dst, b, h) do { _Pragma("unroll") for (int n = 0; n < 2; ++n) _Pragma("unroll") for (int k = 0; k < 2; ++k) dst[n][k] = *(const LAS bf16x8*)(lds + PG8_SB(b, h) + boff + n * 2048 + k * 1024); } while (0)
#define PG8_MMA(ai, bj, At, Bt_) do { __builtin_amdgcn_s_setprio(1); _Pragma("unroll") for (int m = 0; m < 4; ++m) _Pragma("unroll") for (int n = 0; n < 2; ++n) _Pragma("unroll") for (int k = 0; k < 2; ++k) \
        acc[ai][bj][m][n] = __builtin_amdgcn_mfma_f32_16x16x32_bf16(Bt_[n][k], At[m][k], acc[ai][bj][m][n], 0, 0, 0); __builtin_amdgcn_s_setprio(0); } while (0)
#define PG8_WAIT_V(n) asm volatile("s_waitcnt vmcnt(" #n ")" ::: "memory")
#define PG8_WAIT_L(n) asm volatile("s_waitcnt lgkmcnt(" #n ")" ::: "memory")
#define PG8_BAR __builtin_amdgcn_s_barrier()
#define PG8_SCHED __builtin_amdgcn_sched_barrier(0)
#define PG8_AOFFS(dst, unit) do { _Pragma("unroll") for (int _i = 0; _i < 2; ++_i) { int R_, C_; stage_rc(tid * 16 + _i * 8192, R_, C_); \
        dst[0][_i] = AO(unit, 0, R_) + (unsigned)(C_ * 2); dst[1][_i] = AO(unit, 1, R_) + (unsigned)(C_ * 2); } } while (0)
    Unit cur, nxt; int ui = 0;
    if (!S.next(0, cur)) return;
    f32x4 acc[2][2][4][2];
#pragma unroll
    for (int a = 0; a < 2; ++a)
#pragma unroll
        for (int b = 0; b < 2; ++b)
#pragma unroll
            for (int m = 0; m < 4; ++m)
#pragma unroll
                for (int n = 0; n < 2; ++n) acc[a][b][m][n] = (f32x4){0.f, 0.f, 0.f, 0.f};
    bf16x8 At[4][2], B0[2][2], B1[2][2];
    unsigned ac[2][2], an[2][2];
    S.a_ready(cur);
    PG8_AOFFS(ac, cur);
    const char* cB = (const char*)Bt + (size_t)cur.pn * tstep;
    PG8_STAGE(PG8_SB(0, 0), cB, voffB); PG8_STAGE(PG8_SB(0, 1), cB + hstep, voffB); PG8_STAGE(PG8_SA(0, 0), Abase, ac[0]); PG8_STAGE(PG8_SA(0, 1), Abase, ac[1]);
    if (wr == 1) PG8_BAR;
    PG8_WAIT_V(2); PG8_BAR;
    PG8_STAGE(PG8_SB(1, 0), cB + kstep, voffB); PG8_STAGE(PG8_SA(1, 0), Abase + kstep, ac[0]); PG8_STAGE(PG8_SB(1, 1), cB + hstep + kstep, voffB);
    PG8_WAIT_V(6); PG8_BAR;
    for (;;) {
        const bool has_next = S.next(ui + 1, nxt);
        if (!has_next) nxt = cur;
        const char* nB = (const char*)Bt + (size_t)nxt.pn * tstep;
        for (int t = 0; t < nt; t += 2) {
            const bool last = (t == nt - 2);
            if (last) { if (has_next) S.a_ready(nxt); PG8_AOFFS(an, nxt); }
            const char* a1 = Abase + (size_t)(t + 1) * kstep;
            const char* a2 = last ? Abase : Abase + (size_t)(t + 2) * kstep; const char* b2 = last ? nB : cB + (size_t)(t + 2) * kstep;
            const char* a3 = a2 + kstep; const char* b3 = b2 + kstep;
            unsigned o2[2][2];
#pragma unroll
            for (int h = 0; h < 2; ++h)
#pragma unroll
                for (int i = 0; i < 2; ++i) o2[h][i] = last ? an[h][i] : ac[h][i];
            PG8_LDB(B0, 0, 0); PG8_LDB(B1, 0, 1); PG8_SCHED; PG8_LDA(At, 0, 0); PG8_STAGE(PG8_SA(1, 1), a1, ac[1]);
            PG8_WAIT_V(8); PG8_WAIT_L(0); PG8_BAR; PG8_MMA(0, 0, At, B0); PG8_MMA(0, 1, At, B1); PG8_BAR; PG8_SCHED;
            PG8_LDA(At, 0, 1); PG8_STAGE(PG8_SB(0, 0), b2, voffB); PG8_STAGE(PG8_SB(0, 1), b2 + hstep, voffB); PG8_STAGE(PG8_SA(0, 0), a2, o2[0]);
            PG8_WAIT_V(8); PG8_WAIT_L(0); PG8_BAR; PG8_MMA(1, 0, At, B0); PG8_MMA(1, 1, At, B1); PG8_BAR; PG8_SCHED;
            PG8_LDB(B0, 1, 0); PG8_LDB(B1, 1, 1); PG8_SCHED; PG8_LDA(At, 1, 0); PG8_STAGE(PG8_SA(0, 1), a2, o2[1]);
            PG8_WAIT_V(8); PG8_WAIT_L(0); PG8_BAR; PG8_MMA(0, 0, At, B0); PG8_MMA(0, 1, At, B1); PG8_BAR; PG8_SCHED;
            PG8_LDA(At, 1, 1); PG8_STAGE(PG8_SB(1, 0), b3, voffB); PG8_STAGE(PG8_SB(1, 1), b3 + hstep, voffB); PG8_STAGE(PG8_SA(1, 0), a3, o2[0]);
            PG8_WAIT_V(8); PG8_WAIT_L(0); PG8_BAR; PG8_MMA(1, 0, At, B0); PG8_MMA(1, 1, At, B1); PG8_BAR; PG8_SCHED;
        }
        if constexpr (ALIGN_EPI) { if (wr == 0) PG8_BAR; }
        bool carried = false;
        if constexpr (Epi::CARRY) { if (cur.e == 0 && has_next) { E.carry(acc, cur, wr, wc, fr, fq); carried = true; } }
        if (!carried) E(acc, cur, wr, wc, fr, fq);
        if (!has_next) break;
        if (!carried) {
#pragma unroll
        for (int a = 0; a < 2; ++a)
#pragma unroll
            for (int b = 0; b < 2; ++b)
#pragma unroll
                for (int m = 0; m < 4; ++m)
#pragma unroll
                    for (int n = 0; n < 2; ++n) acc[a][b][m][n] = (f32x4){0.f, 0.f, 0.f, 0.f};
        }
        cur = nxt; cB = nB; ++ui;
#pragma unroll
        for (int h = 0; h < 2; ++h)
#pragma unroll
            for (int i = 0; i < 2; ++i) ac[h][i] = an[h][i];
        if constexpr (ALIGN_EPI) { if (wr == 1) PG8_BAR; }
    }
    PG8_WAIT_V(0);
    if constexpr (!ALIGN_EPI) { if (wr == 0) PG8_BAR; }
    PG8_BAR;
#undef PG8_SA
#undef PG8_SB
#undef PG8_STAGE
#undef PG8_LDA
#undef PG8_LDB
#undef PG8_MMA
#undef PG8_WAIT_V
#undef PG8_WAIT_L
#undef PG8_BAR
#undef PG8_SCHED
#undef PG8_AOFFS
}

struct DenseA { unsigned rowbytes; __device__ __forceinline__ unsigned operator()(const Unit& u, int h, int R) const { return (unsigned)(u.pm * BM + h * HALF + R) * rowbytes; } };

struct StaticOrder {
    int nM, nN, nwg, G, c;
    __device__ __forceinline__ void init(int M, int N, int G_, int c_) { nM = M / BM; nN = N / BM; nwg = nM * nN; G = G_; c = c_; }
    __device__ __forceinline__ bool next(int i, Unit& u) const {
        const long L = (long)i * G + c; if (L >= nwg) return false;
        int wgid = (int)L; { const int q = nwg / 8, r = nwg % 8, xcd = wgid % 8, off = wgid / 8; wgid = (xcd < r ? xcd * (q + 1) : r * (q + 1) + (xcd - r) * q) + off; }
        const int nig = 8 * nN, gid = wgid / nig, fm = gid * 8, gsz = (nM - fm) < 8 ? (nM - fm) : 8;
        u.pm = fm + ((wgid % nig) % gsz); u.pn = (wgid % nig) / gsz; u.e = 0; u.r0 = 0; return true;
    }
    __device__ __forceinline__ void a_ready(const Unit&) const {}
};

struct Args { const float* in[32]; float* out; unsigned char* ws; int ph_lo, ph_hi; };


#define XB_TMO      128
#define XB_XCNT(j)  (256  + 64 * (j))
#define XB_XSUB(j)  (1280 + 64 * (j))
#define XB_XGEN(j)  (2304 + 64 * (j))
#define XB_TOP      3328
#define XB_TOPGEN   3392
#define XCD_BAR_WORDS 3456
#define XB_SPIN_CAP (1u << 18)
__device__ __forceinline__ unsigned xb_ld(unsigned* p)              { return __hip_atomic_load(p, __ATOMIC_RELAXED, __HIP_MEMORY_SCOPE_AGENT); }
__device__ __forceinline__ unsigned xb_add(unsigned* p, unsigned v) { return __hip_atomic_fetch_add(p, v, __ATOMIC_RELAXED, __HIP_MEMORY_SCOPE_AGENT); }
__device__ __forceinline__ unsigned xb_xcc_id() { return (unsigned)__builtin_amdgcn_s_getreg((3 << 11) | 20) & 0xFu; }
#define XB_SPIN(cond, bar) do { unsigned _sp = 0; while (cond) { __builtin_amdgcn_s_sleep(1); \
    if ((++_sp & 255u) == 0u) { if (xb_ld(&(bar)[XB_TMO])) break; if (_sp > XB_SPIN_CAP) { atomicAdd(&(bar)[XB_TMO], 1u); break; } } } } while (0)
struct XcdBarrier { unsigned* bar; unsigned x; volatile LAS unsigned* st; };
__device__ __forceinline__ XcdBarrier xcd_barrier_post(unsigned* bar, volatile LAS unsigned* st) {
    XcdBarrier b; b.bar = bar; b.x = xb_xcc_id(); b.st = st;
    if (threadIdx.x == 0) (void)xb_add(&bar[XB_XCNT(b.x)], 1u);
    return b;
}
__device__ __forceinline__ void xcd_barrier_complete(unsigned* bar, unsigned x, unsigned& nloc, unsigned& nx) {
    const unsigned G = gridDim.x * gridDim.y * gridDim.z;
    unsigned sum, cnt, mine, sp = 0u;
    for (;;) {
        sum = 0u; cnt = 0u; mine = 0u;
#pragma unroll
        for (unsigned j = 0; j < 16; ++j) { const unsigned c = xb_ld(&bar[XB_XCNT(j)]); sum += c; cnt += (c > 0u) ? 1u : 0u; mine = (j == x) ? c : mine; }
        if (sum == G) break;
        __builtin_amdgcn_s_sleep(1);
        if ((++sp & 255u) == 0u) { if (xb_ld(&bar[XB_TMO])) break; if (sp > XB_SPIN_CAP) { atomicAdd(&bar[XB_TMO], 1u); break; } }
    }
    nloc = mine > 0u ? mine : 1u; nx = cnt > 0u ? cnt : 1u;
}
__device__ __forceinline__ void xcd_barrier(const XcdBarrier& b) {
    asm volatile("s_waitcnt vmcnt(0)" ::: "memory");
    __syncthreads();
    if (threadIdx.x == 0) {
        unsigned* bar = b.bar;
        __builtin_amdgcn_s_waitcnt(0);
        unsigned nloc = b.st[0], nx = b.st[1];
        if (nloc == 0u) { xcd_barrier_complete(bar, b.x, nloc, nx); b.st[0] = nloc; b.st[1] = nx; }
        const unsigned old = xb_add(&bar[XB_XSUB(b.x)], 1u);
        const unsigned gen = old / nloc;
        if (old + 1u == (gen + 1u) * nloc) {
            __builtin_amdgcn_fence(__ATOMIC_RELEASE, "agent");
            asm volatile("s_waitcnt vmcnt(0)" ::: "memory");
            const unsigned og = xb_add(&bar[XB_TOP], 1u);
            const unsigned tg = og / nx;
            if (og + 1u == (tg + 1u) * nx) xb_add(&bar[XB_TOPGEN], 1u);
            else XB_SPIN(xb_ld(&bar[XB_TOPGEN]) == tg, bar);
            __builtin_amdgcn_fence(__ATOMIC_ACQUIRE, "agent");
            xb_add(&bar[XB_XGEN(b.x)], 1u);
            asm volatile("s_waitcnt vmcnt(0)" ::: "memory");
        } else {
            XB_SPIN(xb_ld(&bar[XB_XGEN(b.x)]) == gen, bar);
            __builtin_amdgcn_fence(__ATOMIC_ACQUIRE, "agent");
            asm volatile("s_waitcnt vmcnt(0)" ::: "memory");
        }
    }
    __syncthreads();
}

constexpr int TAB_BASE = LDS_BYTES - 4096;
constexpr int XBST_OFF = TAB_BASE + 640;
constexpr int PTAB_OFF = TAB_BASE + 128;
__device__ __forceinline__ unsigned long long ptab_get(LAS unsigned char* lds, int k) {
    const LAS unsigned* p = (const LAS unsigned*)(lds + PTAB_OFF) + 2 * k;
    const unsigned lo = __builtin_amdgcn_readfirstlane(p[0]), hi = __builtin_amdgcn_readfirstlane(p[1]);
    return ((unsigned long long)hi << 32) | lo;
}
#define INP(k) ((const float*)(const GAS float*)ptab_get(F.lds, (k)))
#define P_OUT ((float*)(GAS float*)ptab_get(F.lds, 32))

struct Frame {
    LAS unsigned char* lds;
    int tid, lane, wave, G, bid;
    unsigned char* ws;
};

__device__ __forceinline__ Frame make_frame(unsigned char* lds_raw) {
    Frame F; F.lds = (LAS unsigned char*)lds_raw;
    int tid = threadIdx.x; asm volatile("" : "+v"(tid));
    F.tid = tid; F.lane = tid & 63; F.wave = __builtin_amdgcn_readfirstlane(tid >> 6);
    F.G = gridDim.x; F.bid = blockIdx.x; F.ws = (unsigned char*)(GAS unsigned char*)ptab_get(F.lds, 33);
    return F;
}
constexpr int CONV_SCR = 64 * 65 * 4;
template <class Src>
__device__ __forceinline__ void tile_load(const Src& src, int nblk, int item, int lane, f32x4 (&v)[16]) {
    const int kb = item / nblk, nb = item % nblk, k0 = 64 * kb, n0 = 64 * nb;
    const int q = lane & 15, ks = lane >> 4;
#pragma unroll
    for (int i = 0; i < 16; ++i) { const float* p = src.ptr(k0 + 4 * i + ks, n0, q); v[i] = p ? __builtin_nontemporal_load((const f32x4*)p) : (f32x4){0.f, 0.f, 0.f, 0.f}; }
}
template <class Src>
__device__ __forceinline__ void tile_store(const Src& src, int K, bf16_t* WT, int nblk, LAS float* scr, int item, int lane, const f32x4 (&v)[16]) {
    const int kb = item / nblk, nb = item % nblk, k0 = 64 * kb, n0 = 64 * nb;
    const int q = lane & 15, ks = lane >> 4;
    const int d0 = src.dst(n0, q, 0), d1 = src.dst(n0, q, 1), d2 = src.dst(n0, q, 2), d3 = src.dst(n0, q, 3);
#pragma unroll
    for (int i = 0; i < 16; ++i) { LAS float* r = scr + (4 * i + ks) * 65; r[d0] = v[i][0]; r[d1] = v[i][1]; r[d2] = v[i][2]; r[d3] = v[i][3]; }
    asm volatile("s_waitcnt lgkmcnt(0)" ::: "memory");
    const int c = lane & 7;
#pragma unroll
    for (int j = 0; j < 8; ++j) { const int n = (lane >> 3) + 8 * j; const LAS float* s = scr + (8 * c) * 65 + n;
        u32x4 o; o.x = pk2(s[0 * 65], s[1 * 65]); o.y = pk2(s[2 * 65], s[3 * 65]); o.z = pk2(s[4 * 65], s[5 * 65]); o.w = pk2(s[6 * 65], s[7 * 65]);
        *(u32x4*)(WT + (size_t)(n0 + n) * K + k0 + 8 * c) = o; }
    asm volatile("s_waitcnt lgkmcnt(0)" ::: "memory");
}
template <class Src>
__device__ __forceinline__ void tile_store_w1(const Src& src, bf16_t* WP, int nblk, LAS float* scr, int item, int lane, const f32x4 (&v)[16]) {
    const int kb = item / nblk, nb = item % nblk, k0 = 64 * kb, n0 = 64 * nb;
    const int q = lane & 15, ks = lane >> 4;
    const int d0 = src.dst(n0, q, 0), d1 = src.dst(n0, q, 1), d2 = src.dst(n0, q, 2), d3 = src.dst(n0, q, 3);
#pragma unroll
    for (int i = 0; i < 16; ++i) { LAS float* r = scr + (4 * i + ks) * 65; r[d0] = v[i][0]; r[d1] = v[i][1]; r[d2] = v[i][2]; r[d3] = v[i][3]; }
    asm volatile("s_waitcnt lgkmcnt(0)" ::: "memory");
    const int c = lane & 7;
#pragma unroll
    for (int j = 0; j < 8; ++j) { const int n = (lane >> 3) + 8 * j; const LAS float* s = scr + (8 * c) * 65 + n;
        u32x4 o; o.x = pk2(s[0 * 65], s[1 * 65]); o.y = pk2(s[2 * 65], s[3 * 65]); o.z = pk2(s[4 * 65], s[5 * 65]); o.w = pk2(s[6 * 65], s[7 * 65]);
        const int ng = n0 + n, k8 = (k0 >> 3) + c;
        *(u32x4*)(WP + ((size_t)(((ng >> 5) * 128 + (k8 >> 1)) * 64 + (k8 & 1) * 32 + (ng & 31))) * 8) = o; }
    asm volatile("s_waitcnt lgkmcnt(0)" ::: "memory");
}
template <class Src>
__device__ __forceinline__ void transpose_tile(const Src& src, int K, bf16_t* WT, int nblk, LAS float* scr, int item, int lane) {
    f32x4 v[16]; tile_load(src, nblk, item, lane, v); tile_store(src, K, WT, nblk, scr, item, lane, v);
}
#define CONV_LOOP(SRC_T, first, stride, count, MK) do { \
        int it_ = (first); f32x4 cur_[16], nxt_[16]; \
        if (it_ < (count)) { SRC_T s_; int K_, nblk_, r_; bf16_t* WT_; MK(it_, s_, K_, WT_, nblk_, r_); tile_load(s_, nblk_, r_, F.lane, cur_); } \
        while (it_ < (count)) { const int itn_ = it_ + (stride); \
            if (itn_ < (count)) { SRC_T s_; int K_, nblk_, r_; bf16_t* WT_; MK(itn_, s_, K_, WT_, nblk_, r_); tile_load(s_, nblk_, r_, F.lane, nxt_); } \
            { SRC_T s_; int K_, nblk_, r_; bf16_t* WT_; MK(it_, s_, K_, WT_, nblk_, r_); tile_store(s_, K_, WT_, nblk_, scr, r_, F.lane, cur_); } \
            _Pragma("unroll") for (int i_ = 0; i_ < 16; ++i_) cur_[i_] = nxt_[i_]; \
            it_ = itn_; } } while (0)
struct SrcPlain { const float* w; int N;
    __device__ __forceinline__ const float* ptr(int k, int n0, int q) const { return w + (size_t)k * N + n0 + 4 * q; }
    __device__ __forceinline__ int dst(int, int q, int e) const { return 4 * q + e; } };
struct SrcW1e { const float* wg; const float* wu;
    __device__ __forceinline__ const float* ptr(int k, int n0, int q) const { const float* w = (const float*)((unsigned long long)wg + (unsigned long long)(q >> 3) * ((unsigned long long)wu - (unsigned long long)wg)); return w + (size_t)k * 512 + (n0 >> 1) + 4 * (q & 7); }
    __device__ __forceinline__ int dst(int, int q, int e) const { return 2 * (4 * (q & 7) + e) + (q >> 3); } };

constexpr size_t OUT_W1E = 32 * MiB;
constexpr int W1E_EARLY = 8;
__device__ __forceinline__ void conv_w1e(Frame& F, const float* wgate, const float* wup, bf16_t* W1e, int e_lo, int e_hi, int first, int stride) {
    LAS float* scr = (LAS float*)(F.lds + F.wave * CONV_SCR);
    constexpr int I1 = (1024 / 64) * (1024 / 64);
#define MK_W1E(it, s, K, WT, nblk, r) do { const int e_ = (it) / I1; r = (it) % I1; s = SrcW1e{wgate + (size_t)e_ * 1024 * 512, wup + (size_t)e_ * 1024 * 512}; K = 1024; WT = W1e + (size_t)e_ * 1024 * 1024; nblk = 16; } while (0)
    CONV_LOOP(SrcW1e, e_lo * I1 + first, stride, e_hi * I1, MK_W1E);
#undef MK_W1E
}

__device__ __forceinline__ void route_phase(Frame& F, const bf16_t* x1, const float* g2, const float* rgw, const float* rgb, const float* rew, const float* reb,
                                            const float* wgate, const float* wup, const float* wdown, bf16_t* W1e, unsigned* x1rdy) {
    unsigned char* ws = F.ws;
    {
        LAS float* scr = (LAS float*)(F.lds + F.wave * CONV_SCR);
        const int gw = F.bid * 8 + F.wave, NGW = F.G * 8;
        bf16_t* WdT = (bf16_t*)(ws + WS_WDT);
        constexpr int I2 = (512 / 64) * (1024 / 64);
#define MK_WDT(it, s, K, WT, nblk, r) do { const int e_ = (it) / I2; r = (it) % I2; s = SrcPlain{wdown + (size_t)e_ * 512 * 1024, 1024}; K = 512; WT = WdT + (size_t)e_ * 1024 * 512; nblk = 16; } while (0)
        conv_w1e(F, wgate, wup, W1e, (F.G == 256) ? W1E_EARLY : 0, 16, gw, NGW);
        CONV_LOOP(SrcPlain, gw, NGW, 16 * I2, MK_WDT);
#undef MK_WDT
    }
    __syncthreads();
    constexpr int XT_S = 264;
    LAS bf16_t* XH = (LAS bf16_t*)(F.lds); LAS bf16_t* XL = XH + 64 * XT_S; LAS bf16_t* WH = XL + 64 * XT_S; LAS bf16_t* WL = WH + 32 * XT_S;
    LAS float* LG = (LAS float*)(F.lds + (2 * 64 + 2 * 32) * XT_S * 2);
    LAS unsigned* lcnt = (LAS unsigned*)(F.lds + (2 * 64 + 2 * 32) * XT_S * 2 + 64 * 33 * 4);
    LAS unsigned* lbase = lcnt + 16;
    LAS unsigned* tinfo = lbase + 16;
    LAS float* tw = (LAS float*)(tinfo + 128);
    unsigned* gcnt = (unsigned*)(ws + WS_GCNT); float* wsl = (float*)(ws + WS_WSL); unsigned* list = (unsigned*)(ws + WS_LIST);
    bf16_t* H2 = (bf16_t*)(ws + WS_H2);
    const bf16_t* WRS = (const bf16_t*)(ws + WS_WRS);
    const int mt = F.wave & 3, nt = F.wave >> 2, fr = F.lane & 15, fq = F.lane >> 4;
    for (int tile = F.bid; tile < T / 64; tile += F.G) {
        if (x1rdy) {
            if (F.tid < 64) {
                unsigned sp = 0;
                while ((unsigned)__builtin_amdgcn_readfirstlane(__hip_atomic_load(x1rdy + 16 * (tile >> 2), __ATOMIC_RELAXED, __HIP_MEMORY_SCOPE_AGENT)) < 32u) { __builtin_amdgcn_s_sleep(2); if (++sp > (1u << 22)) break; }
                __builtin_amdgcn_fence(__ATOMIC_ACQUIRE, "agent");
            }
            __syncthreads();
        }
        if (F.tid < 16) lcnt[F.tid] = 0u;
        const int tk0 = F.wave * 8, t0 = tile * 64 + tk0;
        u32x2 xr[8][4]; float rinv[8];
#pragma unroll
        for (int u = 0; u < 8; ++u) { const u32x2* xp = (const u32x2*)(x1 + (size_t)(t0 + u) * D) + F.lane;
#pragma unroll
            for (int j = 0; j < 4; ++j) xr[u][j] = xp[64 * j]; }
#pragma unroll
        for (int u = 0; u < 8; ++u) { float ss = 0.f;
#pragma unroll
            for (int j = 0; j < 4; ++j) { const float a = __builtin_bit_cast(float, xr[u][j].x << 16), b = __builtin_bit_cast(float, xr[u][j].x & 0xffff0000u), c = __builtin_bit_cast(float, xr[u][j].y << 16), d = __builtin_bit_cast(float, xr[u][j].y & 0xffff0000u);
                ss += (a * a + b * b) + (c * c + d * d); }
            rinv[u] = rsqrtf(wave_sum_dpp(ss) * (1.f / D) + 1e-6f); }
        f32x4 acc = (f32x4){0.f, 0.f, 0.f, 0.f};
#pragma unroll 1
        for (int j = 0; j < 4; ++j) {
            u32x4 wq[4];
#pragma unroll
            for (int i = 0; i < 4; ++i) { const int pc = F.tid + 512 * i, hl = pc >> 10, n = (pc >> 5) & 31, c8 = pc & 31; wq[i] = *(const u32x4*)(WRS + (size_t)hl * 32 * 1024 + (size_t)n * 1024 + 256 * j + 8 * c8); }
            const f32x4 gv = ((const f32x4*)g2)[F.lane + 64 * j];
#pragma unroll
            for (int u = 0; u < 8; ++u) { const u32x2 xb = (j == 0) ? xr[u][0] : (j == 1) ? xr[u][1] : (j == 2) ? xr[u][2] : xr[u][3];
                f32x4 h; h.x = __builtin_bit_cast(float, xb.x << 16); h.y = __builtin_bit_cast(float, xb.x & 0xffff0000u); h.z = __builtin_bit_cast(float, xb.y << 16); h.w = __builtin_bit_cast(float, xb.y & 0xffff0000u);
                h = h * rinv[u] * gv;
                const unsigned p0 = pk2(h.x, h.y), p1 = pk2(h.z, h.w);
                ((unsigned long long*)(H2 + (size_t)(t0 + u) * D) + F.lane)[64 * j] = (unsigned long long)p0 | ((unsigned long long)p1 << 32);
                const unsigned q0 = pk2(h.x - __builtin_bit_cast(float, p0 << 16), h.y - __builtin_bit_cast(float, p0 & 0xffff0000u)), q1 = pk2(h.z - __builtin_bit_cast(float, p1 << 16), h.w - __builtin_bit_cast(float, p1 & 0xffff0000u));
                *(LAS u32x2*)(XH + (tk0 + u) * XT_S + 4 * F.lane) = (u32x2){p0, p1}; *(LAS u32x2*)(XL + (tk0 + u) * XT_S + 4 * F.lane) = (u32x2){q0, q1}; }
#pragma unroll
            for (int i = 0; i < 4; ++i) { const int pc = F.tid + 512 * i, hl = pc >> 10, n = (pc >> 5) & 31, c8 = pc & 31; *(LAS u32x4*)((hl ? WL : WH) + n * XT_S + 8 * c8) = wq[i]; }
            __syncthreads();
#pragma unroll
            for (int ks = 0; ks < 8; ++ks) {
                const bf16x8 bhk = *(const LAS bf16x8*)(WH + (16 * nt + fr) * XT_S + 32 * ks + 8 * fq), blk = *(const LAS bf16x8*)(WL + (16 * nt + fr) * XT_S + 32 * ks + 8 * fq);
                const bf16x8 ah = *(const LAS bf16x8*)(XH + (16 * mt + fr) * XT_S + 32 * ks + 8 * fq), al = *(const LAS bf16x8*)(XL + (16 * mt + fr) * XT_S + 32 * ks + 8 * fq);
                acc = __builtin_amdgcn_mfma_f32_16x16x32_bf16(ah, bhk, acc, 0, 0, 0); acc = __builtin_amdgcn_mfma_f32_16x16x32_bf16(ah, blk, acc, 0, 0, 0); acc = __builtin_amdgcn_mfma_f32_16x16x32_bf16(al, bhk, acc, 0, 0, 0);
            }
            __syncthreads();
        }
#pragma unroll
        for (int r = 0; r < 4; ++r) LG[(16 * mt + 4 * fq + r) * 33 + 16 * nt + fr] = acc[r];
        __syncthreads();
        if (F.tid < 64) {
            const int tk = F.tid, t = tile * 64 + tk; float lg[20];
#pragma unroll
            for (int q = 0; q < 20; ++q) lg[q] = LG[tk * 33 + q];
            const float gl0 = lg[0] + rgb[0], gl1 = lg[1] + rgb[1], gl2 = lg[2] + rgb[2], gl3 = lg[3] + rgb[3];
            int gi = 0; float gb = gl0;
            if (gl1 > gb) { gb = gl1; gi = 1; } if (gl2 > gb) { gb = gl2; gi = 2; } if (gl3 > gb) { gb = gl3; gi = 3; }
            const float gs = expf(gl0 - gb) + expf(gl1 - gb) + expf(gl2 - gb) + expf(gl3 - gb);
            const float gwt = 1.0f / gs;
            float e0 = gi == 0 ? lg[4] : gi == 1 ? lg[8] : gi == 2 ? lg[12] : lg[16];
            float e1 = gi == 0 ? lg[5] : gi == 1 ? lg[9] : gi == 2 ? lg[13] : lg[17];
            float e2 = gi == 0 ? lg[6] : gi == 1 ? lg[10] : gi == 2 ? lg[14] : lg[18];
            float e3 = gi == 0 ? lg[7] : gi == 1 ? lg[11] : gi == 2 ? lg[15] : lg[19];
            e0 += reb[gi * 4 + 0]; e1 += reb[gi * 4 + 1]; e2 += reb[gi * 4 + 2]; e3 += reb[gi * 4 + 3];
            const float em = fmaxf(fmaxf(e0, e1), fmaxf(e2, e3));
            const float p0 = expf(e0 - em), p1 = expf(e1 - em), p2 = expf(e2 - em), p3 = expf(e3 - em);
            int i0 = 0; float b0 = p0;
            if (p1 > b0) { b0 = p1; i0 = 1; } if (p2 > b0) { b0 = p2; i0 = 2; } if (p3 > b0) { b0 = p3; i0 = 3; }
            int i1 = -1; float b1 = -1.f;
            if (i0 != 0 && p0 > b1) { b1 = p0; i1 = 0; } if (i0 != 1 && p1 > b1) { b1 = p1; i1 = 1; } if (i0 != 2 && p2 > b1) { b1 = p2; i1 = 2; } if (i0 != 3 && p3 > b1) { b1 = p3; i1 = 3; }
            const float den = b0 + b1;
            const int ea = gi * 4 + i0, eb = gi * 4 + i1;
            const unsigned ra = atomicAdd((unsigned*)&lcnt[ea], 1u), rb = atomicAdd((unsigned*)&lcnt[eb], 1u);
            tinfo[tk * 2 + 0] = (unsigned)ea | (ra << 4); tinfo[tk * 2 + 1] = (unsigned)eb | (rb << 4);
            tw[tk * 2 + 0] = gwt * (b0 / den); tw[tk * 2 + 1] = gwt * (b1 / den);
        }
        __syncthreads();
        if (F.tid < 16) lbase[F.tid] = atomicAdd(&gcnt[F.tid], lcnt[F.tid]);
        __syncthreads();
        if (F.tid < 128) { const unsigned info = tinfo[F.tid]; const unsigned e = info & 15u, r = info >> 4; const size_t pos = (size_t)e * T + lbase[e] + r; list[pos] = (unsigned)((tile * 64 + (F.tid >> 1)) * 2 + (F.tid & 1)); wsl[pos] = tw[F.tid]; }
        __syncthreads();
    }
}
#ifndef MOE_DBL
#define MOE_DBL 0
#endif
struct MoeSched {
    const LAS int* pre;
    int G, c, npn;
    int second;
    unsigned* ready;
    __device__ __forceinline__ void a_ready(const Unit& u) const {
        if (ready == nullptr) return;
        if (threadIdx.x < 64) {
            unsigned sp = 0;
            while ((unsigned)__builtin_amdgcn_readfirstlane(__hip_atomic_load(ready + 16 * u.pm, __ATOMIC_RELAXED, __HIP_MEMORY_SCOPE_AGENT)) < (32u << MOE_DBL)) { __builtin_amdgcn_s_sleep(2); if (++sp > (1u << 22)) break; }
            __builtin_amdgcn_fence(__ATOMIC_ACQUIRE, "agent");
            asm volatile("s_waitcnt vmcnt(0)" ::: "memory");
        }
        asm volatile("" ::: "memory"); __builtin_amdgcn_s_barrier(); asm volatile("" ::: "memory");
    }
    __device__ __forceinline__ bool next(int i_, Unit& u) const {
        const int i = i_ >> MOE_DBL;
        int e, rt, pl, L;
        const int nun = pre[16] * npn;
        if (G == 256) {
            const int v = (c & 7) * 32 + (c >> 3);
            const int r1 = nun & 255, nl = 256 - r1;
            if (!second) L = i * 256 + v;
            else if (v >= r1) L = (i == 0) ? (v - r1) : (i == 1) ? nl + (v - r1) : 2 * nl + (i - 2) * 256 + v;
            else L = 2 * nl + i * 256 + v;
        } else L = i * G + c;
        if (L >= nun) return false;
        rt = L / npn; pl = L % npn; e = 0;
#pragma unroll
        for (int q = 1; q < 16; ++q) e += (rt >= pre[q]) ? 1 : 0;
        u.pm = __builtin_amdgcn_readfirstlane(rt); u.pn = __builtin_amdgcn_readfirstlane(e * npn + pl); u.e = __builtin_amdgcn_readfirstlane(e); u.r0 = __builtin_amdgcn_readfirstlane((rt - pre[e]) * BM); return true;
    }
};
struct GatherA {
    static constexpr bool DENSE = false;
    __device__ __forceinline__ size_t ubase(const Unit&) const { return 0; }
    const unsigned* list; const unsigned* gcnt;
    __device__ __forceinline__ unsigned operator()(const Unit& u, int h, int R) const {
        const int rank = u.r0 + h * HALF + R; const unsigned cnt = gcnt[u.e];
        const unsigned ent = ((unsigned)rank < cnt) ? list[(size_t)u.e * T + rank] : 0u;
        return (ent >> 1) * (unsigned)(D * 2);
    }
};
__device__ __forceinline__ float silu_f(float x) { return x * __builtin_amdgcn_rcpf(1.0f + __builtin_amdgcn_exp2f(-1.4426950408889634f * x)); }
struct EpiMoe1 {
    static constexpr bool PERM = true; static constexpr bool CARRY = false;
    bf16_t* ACT; unsigned* ready;
    __device__ __forceinline__ void operator()(const f32x4 (&acc)[2][2][4][2], const Unit& u, int wr, int wc, int fr, int fq) const {
        const int row0 = u.pm * BM + wr * 64 + fr; const int ch0 = (u.pn & 3) * 128 + wc * 16 + 4 * fq;
#pragma unroll
        for (int ai = 0; ai < 2; ++ai)
#pragma unroll
            for (int m = 0; m < 4; ++m) { bf16_t* rowp = ACT + (size_t)(row0 + ai * HALF + m * 16) * 512 + ch0;
#pragma unroll
                for (int bj = 0; bj < 2; ++bj) { const f32x4 v0 = acc[ai][bj][m][0], v1 = acc[ai][bj][m][1];
                    u32x2 w; w.x = pk2(silu_f(v0[0]) * v0[1], silu_f(v0[2]) * v0[3]); w.y = pk2(silu_f(v1[0]) * v1[1], silu_f(v1[2]) * v1[3]);
                    __hip_atomic_store((unsigned long long*)(rowp + bj * 64), (unsigned long long)w.x | ((unsigned long long)w.y << 32), __ATOMIC_RELAXED, __HIP_MEMORY_SCOPE_AGENT); } }
        asm volatile("s_waitcnt vmcnt(0)" ::: "memory");
        if ((threadIdx.x & 63) == 0) __hip_atomic_fetch_add(ready + 16 * u.pm, 1u, __ATOMIC_RELAXED, __HIP_MEMORY_SCOPE_AGENT);
    }
};
typedef DenseA DenseAct;
struct EpiMoe2 {
    static constexpr bool PERM = true; static constexpr bool CARRY = false;
    bf16_t* Y0; bf16_t* Y1; const unsigned* list; const unsigned* gcnt; const float* wsl;
    __device__ __forceinline__ void operator()(const f32x4 (&acc)[2][2][4][2], const Unit& u, int wr, int wc, int fr, int fq) const {
        const unsigned cnt = gcnt[u.e]; const int col0 = (u.pn & 3) * BM + wc * 32 + 8 * fq;
        unsigned ent[8]; float w[8];
#pragma unroll
        for (int i = 0; i < 8; ++i) { const int rank = u.r0 + (i >> 2) * HALF + wr * 64 + (i & 3) * 16 + fr; ent[i] = ((unsigned)rank < cnt) ? list[(size_t)u.e * T + rank] : 0xffffffffu; }
#pragma unroll
        for (int i = 0; i < 8; ++i) { const int rank = u.r0 + (i >> 2) * HALF + wr * 64 + (i & 3) * 16 + fr; w[i] = ((unsigned)rank < cnt) ? wsl[(size_t)u.e * T + rank] : 0.f; }
#pragma unroll
        for (int ai = 0; ai < 2; ++ai)
#pragma unroll
            for (int m = 0; m < 4; ++m) {
                const unsigned en = ent[ai * 4 + m]; const float wv = w[ai * 4 + m];
                if (en != 0xffffffffu) {
                    bf16_t* rowp = (bf16_t*)((unsigned long long)Y0 + (unsigned long long)(en & 1u) * ((unsigned long long)Y1 - (unsigned long long)Y0)) + (size_t)(en >> 1) * D + col0;
#pragma unroll
                    for (int bj = 0; bj < 2; ++bj) { const f32x4 v0 = acc[ai][bj][m][0] * wv, v1 = acc[ai][bj][m][1] * wv;
                        u32x4 o; o.x = pk2(v0[0], v0[1]); o.y = pk2(v0[2], v0[3]); o.z = pk2(v1[0], v1[1]); o.w = pk2(v1[2], v1[3]);
                        *(u32x4*)(rowp + bj * HALF) = o; }
                }
            }
    }
};
__device__ __forceinline__ void moe_prefix(Frame& F, LAS int* pre) {
    if (F.tid == 0) { const unsigned* gcnt = (const unsigned*)(F.ws + WS_GCNT); int s = 0; for (int e = 0; e < 16; ++e) { pre[e] = s; s += (int)((gcnt[e] + 255u) >> 8); } pre[16] = s; }
    __syncthreads();
}

__device__ __forceinline__ void final_phase(Frame& F, const bf16_t* xi, float* xo, const float* gf) {
    const bf16_t* Y0 = (const bf16_t*)(F.ws + WS_Y0); const bf16_t* Y1 = (const bf16_t*)(F.ws + WS_Y1);
    const int gw = F.bid * 8 + F.wave, NGW = F.G * 8;
    f32x4 gv4[4];
#pragma unroll
    for (int j = 0; j < 4; ++j) gv4[j] = ((const f32x4*)gf)[F.lane + 64 * j];
#pragma unroll 1
    for (int t = gw; t < T; t += 8 * NGW) {
        u32x2 xb[8][4], ya[8][4], yb[8][4];
#pragma unroll
        for (int u = 0; u < 8; ++u) { const int tr = (t + u * NGW < T) ? t + u * NGW : t;
            const u32x2* xr = (const u32x2*)(xi + (size_t)tr * D) + F.lane; const u32x2* y0 = (const u32x2*)(Y0 + (size_t)tr * D) + F.lane; const u32x2* y1 = (const u32x2*)(Y1 + (size_t)tr * D) + F.lane;
#pragma unroll
            for (int j = 0; j < 4; ++j) { xb[u][j] = __builtin_nontemporal_load(&xr[64 * j]); ya[u][j] = __builtin_nontemporal_load(&y0[64 * j]); yb[u][j] = __builtin_nontemporal_load(&y1[64 * j]); } }
#pragma unroll
        for (int u = 0; u < 8; ++u) { const int tr = t + u * NGW; f32x4 v[4]; float ss = 0.f;
#pragma unroll
            for (int j = 0; j < 4; ++j) { const u32x2 x2 = xb[u][j], a = ya[u][j], b = yb[u][j];
                v[j].x = __builtin_bit_cast(float, x2.x << 16) + (__builtin_bit_cast(float, a.x << 16) + __builtin_bit_cast(float, b.x << 16));
                v[j].y = __builtin_bit_cast(float, x2.x & 0xffff0000u) + (__builtin_bit_cast(float, a.x & 0xffff0000u) + __builtin_bit_cast(float, b.x & 0xffff0000u));
                v[j].z = __builtin_bit_cast(float, x2.y << 16) + (__builtin_bit_cast(float, a.y << 16) + __builtin_bit_cast(float, b.y << 16));
                v[j].w = __builtin_bit_cast(float, x2.y & 0xffff0000u) + (__builtin_bit_cast(float, a.y & 0xffff0000u) + __builtin_bit_cast(float, b.y & 0xffff0000u));
                ss += (v[j].x * v[j].x + v[j].y * v[j].y) + (v[j].z * v[j].z + v[j].w * v[j].w); }
            const float rinv = rsqrtf(wave_sum(ss) * (1.f / D) + 1e-6f);
            if (tr < T) { f32x4* xw = (f32x4*)(xo + (size_t)tr * D) + F.lane;
#pragma unroll
                for (int j = 0; j < 4; ++j) __builtin_nontemporal_store(v[j] * rinv * gv4[j], &xw[64 * j]); }
        }
    }
}

struct AttnPtrs { const bf16_t *Q, *KS, *VS, *KW, *VW, *KC, *VC; const float* NG; bf16_t* O; int nb; unsigned* ready; unsigned* ordy; };
typedef short v4i16_t __attribute__((ext_vector_type(4)));
constexpr int AT_K = 0  , AT_V = 32768  , AT_PSUM = 81920, AT_SCR = AT_PSUM + 4 * 64 * 33 * 4  , AT_OACC = AT_PSUM  ,
              AT_WSF = AT_OACC + 65536, AT_SELM = AT_WSF + 8 * 64 * 4, AT_END = AT_SELM + 256;
static_assert(AT_SCR + 64 * 32 * 4 <= AT_WSF, "attention LDS map");
static_assert(AT_END <= LDS_BYTES - 4096, "attention LDS map");
constexpr float MASKV = -1.0e30f;

__device__ __forceinline__ void swap32(float& a, float& b) { asm volatile("s_nop 1\n\tv_permlane32_swap_b32_e32 %0, %1" : "+v"(a), "+v"(b)); }
__device__ __forceinline__ float xhalf_max(float v) { float a = v, b = v; swap32(a, b); return fmaxf(a, b); }
__device__ __forceinline__ float xhalf_sum(float v) { float a = v, b = v; swap32(a, b); return a + b; }
template <int XM> __device__ __forceinline__ unsigned swz_xor(unsigned v) { return (unsigned)__builtin_amdgcn_ds_swizzle((int)v, (XM << 10) | 0x1f); }
__device__ __forceinline__ int crow(int r, int hi) { return (r & 3) + 8 * (r >> 2) + 4 * hi; }
__device__ __forceinline__ float mask_neg(float p, int x) { return fmaf((float)(x >> 31), 1.0e30f, p); }
__device__ __forceinline__ int k_src_chunk(int key, int slot) { return slot ^ ((key >> 1) & 7); }
__device__ __forceinline__ int v_src_chunk(int key, int slot) { return slot ^ (((key >> 1) & 1) << 2); }
__device__ __forceinline__ void kv_load(const bf16_t* Kp, const bf16_t* Vp, long row0, int g, int tid, u32x4& kr, u32x4& vr) {
    const int key = tid >> 3, slot = tid & 7;
    kr = *(const u32x4*)(Kp + (row0 + key) * 256 + g * 64 + k_src_chunk(key, slot) * 8);
    vr = *(const u32x4*)(Vp + (row0 + key) * 256 + g * 64 + v_src_chunk(key, slot) * 8);
}
__device__ __forceinline__ void kv_store(LAS unsigned char* lds, int buf, int tid, const u32x4& kr, const u32x4& vr) {
    *(LAS u32x4*)(lds + AT_K + buf * 8192 + tid * 16) = kr; *(LAS u32x4*)(lds + AT_V + buf * 8192 + tid * 16) = vr;
}
__device__ __forceinline__ int k_frag_off(int key, int chunk) { return key * 128 + ((chunk ^ ((key >> 1) & 7)) << 4); }
__device__ __forceinline__ void qk_tile(const LAS unsigned char* Kb, const bf16x8 (&qr)[4], int r32, int hi, f32x16& p0, f32x16& p1) {
#pragma unroll
    for (int r = 0; r < 16; ++r) { p0[r] = 0.f; p1[r] = 0.f; }
#pragma unroll
    for (int d0 = 0; d0 < 4; ++d0) {
        const bf16x8 a0 = *(const LAS bf16x8*)(Kb + k_frag_off(r32, 2 * d0 + hi));
        const bf16x8 a1 = *(const LAS bf16x8*)(Kb + k_frag_off(r32, 2 * d0 + hi) + 4096);
        p0 = __builtin_amdgcn_mfma_f32_32x32x16_bf16(a0, qr[d0], p0, 0, 0, 0);
        p1 = __builtin_amdgcn_mfma_f32_32x32x16_bf16(a1, qr[d0], p1, 0, 0, 0);
    }
}
__device__ __forceinline__ bf16x8 pack8(const f32x16& p, int base) {
    u32x4 w; w.x = pk2(p[base + 0], p[base + 1]); w.y = pk2(p[base + 2], p[base + 3]); w.z = pk2(p[base + 4], p[base + 5]); w.w = pk2(p[base + 6], p[base + 7]);
    return __builtin_bit_cast(bf16x8, w);
}
template <bool LSUM>
__device__ __forceinline__ void pv_tile_l(const LAS unsigned char* Vb, int lane, const f32x16& p0, const f32x16& p1, f32x16 (&o)[2], f32x16& lacc, const bf16x8& ones) {
    const int hi = lane >> 5;
    const int qp = (lane & 15) >> 2, sw = (qp >> 1) & 1;
    const LAS unsigned char* vp = Vb + (4 * hi + qp) * 128 + ((lane >> 4) & 1) * 32 + (lane & 3) * 8;
    const bf16x8 pa0 = pack8(p0, 0), pa1 = pack8(p0, 8), pa2 = pack8(p1, 0), pa3 = pack8(p1, 8);
    if (LSUM) {
        lacc = __builtin_amdgcn_mfma_f32_32x32x16_bf16(pa0, ones, lacc, 0, 0, 0); lacc = __builtin_amdgcn_mfma_f32_32x32x16_bf16(pa1, ones, lacc, 0, 0, 0);
        lacc = __builtin_amdgcn_mfma_f32_32x32x16_bf16(pa2, ones, lacc, 0, 0, 0); lacc = __builtin_amdgcn_mfma_f32_32x32x16_bf16(pa3, ones, lacc, 0, 0, 0);
    }
#pragma unroll
    for (int d0 = 0; d0 < 2; ++d0) {
#pragma unroll
        for (int ks = 0; ks < 4; ++ks) {
            const v4i16_t lo = __builtin_amdgcn_ds_read_tr16_b64_v4i16((LAS v4i16_t*)(vp + ((d0 ^ sw) << 6) + ks * 2048));
            const v4i16_t hh = __builtin_amdgcn_ds_read_tr16_b64_v4i16((LAS v4i16_t*)(vp + ((d0 ^ sw) << 6) + ks * 2048 + 1024));
            const bf16x8 vf = (bf16x8){lo[0], lo[1], lo[2], lo[3], hh[0], hh[1], hh[2], hh[3]};
            const bf16x8 pa = ks == 0 ? pa0 : ks == 1 ? pa1 : ks == 2 ? pa2 : pa3;
            o[d0] = __builtin_amdgcn_mfma_f32_32x32x16_bf16(pa, vf, o[d0], 0, 0, 0);
        }
    }
}
__device__ __forceinline__ void pv_tile(const LAS unsigned char* Vb, int lane, const f32x16& p0, const f32x16& p1, f32x16 (&o)[2]) {
    const int hi = lane >> 5;
    const int qp = (lane & 15) >> 2, sw = (qp >> 1) & 1;
    const LAS unsigned char* vp = Vb + (4 * hi + qp) * 128 + ((lane >> 4) & 1) * 32 + (lane & 3) * 8;
    const bf16x8 pa0 = pack8(p0, 0), pa1 = pack8(p0, 8), pa2 = pack8(p1, 0), pa3 = pack8(p1, 8);
#pragma unroll
    for (int d0 = 0; d0 < 2; ++d0) {
#pragma unroll
        for (int ks = 0; ks < 4; ++ks) {
            const v4i16_t lo = __builtin_amdgcn_ds_read_tr16_b64_v4i16((LAS v4i16_t*)(vp + ((d0 ^ sw) << 6) + ks * 2048));
            const v4i16_t hh = __builtin_amdgcn_ds_read_tr16_b64_v4i16((LAS v4i16_t*)(vp + ((d0 ^ sw) << 6) + ks * 2048 + 1024));
            const bf16x8 vf = (bf16x8){lo[0], lo[1], lo[2], lo[3], hh[0], hh[1], hh[2], hh[3]};
            const bf16x8 pa = ks == 0 ? pa0 : ks == 1 ? pa1 : ks == 2 ? pa2 : pa3;
            o[d0] = __builtin_amdgcn_mfma_f32_32x32x16_bf16(pa, vf, o[d0], 0, 0, 0);
        }
    }
}
constexpr float RESC_THR = 8.0f;
__device__ __forceinline__ void softmax_step(f32x16& p0, f32x16& p1, float& m_run, float& l_run, f32x16 (&o)[2], LAS float* wsf, int lane) {
    const int q = lane & 31, hi = lane >> 5;
    float mt = p0[0];
#pragma unroll
    for (int r = 1; r < 16; ++r) mt = fmaxf(mt, p0[r]);
#pragma unroll
    for (int r = 0; r < 16; ++r) mt = fmaxf(mt, p1[r]);
    mt = xhalf_max(mt);
    if (__any(mt > m_run + RESC_THR)) {
        const float mn = fmaxf(m_run, mt);
        const float alpha = __builtin_amdgcn_exp2f(m_run - mn);
        m_run = mn; l_run *= alpha;
        if (hi == 0) wsf[q] = alpha;
        asm volatile("s_waitcnt lgkmcnt(0)" ::: "memory");
#pragma unroll
        for (int r4 = 0; r4 < 4; ++r4) { const f32x4 a4 = *(const LAS f32x4*)(wsf + 8 * r4 + 4 * hi);
#pragma unroll
            for (int j = 0; j < 4; ++j) { o[0][4 * r4 + j] *= a4[j]; o[1][4 * r4 + j] *= a4[j]; } }
        asm volatile("" ::: "memory");
    }
    float sum = 0.f;
#pragma unroll
    for (int r = 0; r < 16; ++r) { p0[r] = __builtin_amdgcn_exp2f(p0[r] - m_run); sum += p0[r]; }
#pragma unroll
    for (int r = 0; r < 16; ++r) { p1[r] = __builtin_amdgcn_exp2f(p1[r] - m_run); sum += p1[r]; }
    l_run += sum;
}
__device__ __forceinline__ void glds16(const void* gsrc, unsigned lds_dst) { unsigned keep;
    asm volatile("s_mov_b32 %0, m0\n\ts_mov_b32 m0, %2\n\ts_nop 0\n\tglobal_load_lds_dwordx4 %1, off\n\ts_mov_b32 m0, %0" : "=&s"(keep) : "v"(gsrc), "s"(lds_dst) : "memory"); }
__device__ __forceinline__ void kv_dma(LAS unsigned char* lds, int slot, int vslot, const bf16_t* Kp, const bf16_t* Vp, long row0, int g, int tid) {
    const int wid = __builtin_amdgcn_readfirstlane(tid >> 6), lane = tid & 63;
    const int key = 8 * wid + (lane >> 3), sl16 = lane & 7;
    const bf16_t* ksrc = Kp + (row0 + key) * 256 + g * 64 + k_src_chunk(key, sl16) * 8;
    const bf16_t* vsrc = Vp + (row0 + key) * 256 + g * 64 + v_src_chunk(key, sl16) * 8;
    const unsigned l0 = (unsigned)(size_t)lds;
    glds16(ksrc, (unsigned)__builtin_amdgcn_readfirstlane(l0 + AT_K + slot * 8192 + wid * 1024));
    glds16(vsrc, (unsigned)__builtin_amdgcn_readfirstlane(l0 + AT_V + vslot * 8192 + wid * 1024));
}
__device__ __forceinline__ void qk_tile_c(const LAS unsigned char* Kb, const bf16x8 (&qr)[4], int r32, int hi, const f32x16& ci, f32x16& p0, f32x16& p1) {
#pragma unroll
    for (int d0 = 0; d0 < 4; ++d0) {
        const bf16x8 a0 = *(const LAS bf16x8*)(Kb + k_frag_off(r32, 2 * d0 + hi));
        const bf16x8 a1 = *(const LAS bf16x8*)(Kb + k_frag_off(r32, 2 * d0 + hi) + 4096);
        if (d0 == 0) { p0 = __builtin_amdgcn_mfma_f32_32x32x16_bf16(a0, qr[0], ci, 0, 0, 0); p1 = __builtin_amdgcn_mfma_f32_32x32x16_bf16(a1, qr[0], ci, 0, 0, 0); }
        else { p0 = __builtin_amdgcn_mfma_f32_32x32x16_bf16(a0, qr[d0], p0, 0, 0, 0); p1 = __builtin_amdgcn_mfma_f32_32x32x16_bf16(a1, qr[d0], p1, 0, 0, 0); }
    }
}
__device__ __forceinline__ float softmax_rel(f32x16& p0, f32x16& p1, bool first, float& m_run, float& l_run, f32x16 (&o)[2], LAS float* wsf, int lane, bool& shifted) {
    const int q = lane & 31, hi = lane >> 5;
    float mt = p0[0];
#pragma unroll
    for (int r = 1; r < 16; ++r) mt = fmaxf(mt, p0[r]);
#pragma unroll
    for (int r = 0; r < 16; ++r) mt = fmaxf(mt, p1[r]);
    mt = xhalf_max(mt);
    float delta = 0.f;
    shifted = first || __any(mt > RESC_THR);
    if (shifted) {
        delta = first ? ((mt > -1.0e29f) ? mt : 0.f) : fmaxf(mt, 0.f);
        m_run += delta;
#pragma unroll
        for (int r = 0; r < 16; ++r) { p0[r] -= delta; p1[r] -= delta; }
        if (!first) {
            const float alpha = __builtin_amdgcn_exp2f(-delta);
            l_run *= alpha;
            if (hi == 0) wsf[q] = alpha;
            asm volatile("s_waitcnt lgkmcnt(0)" ::: "memory");
#pragma unroll
            for (int r4 = 0; r4 < 4; ++r4) { const f32x4 a4 = *(const LAS f32x4*)(wsf + 8 * r4 + 4 * hi);
#pragma unroll
                for (int j = 0; j < 4; ++j) { o[0][4 * r4 + j] *= a4[j]; o[1][4 * r4 + j] *= a4[j]; } }
            asm volatile("" ::: "memory");
        }
    }
    float sum = 0.f;
#pragma unroll
    for (int r = 0; r < 16; ++r) { p0[r] = __builtin_amdgcn_exp2f(p0[r]); sum += p0[r]; }
#pragma unroll
    for (int r = 0; r < 16; ++r) { p1[r] = __builtin_amdgcn_exp2f(p1[r]); sum += p1[r]; }
    l_run += sum;
    return delta;
}
__device__ __forceinline__ float max3f(float a, float b, float c) { float d; asm volatile("v_max3_f32 %0, %1, %2, %3" : "=v"(d) : "v"(a), "v"(b), "v"(c)); return d; }
__device__ __forceinline__ void softmax_rel2(f32x16& p0, f32x16& p1, f32x16& p2, f32x16& p3, bool first, float& m_run, f32x16& cm, f32x16& lacc, f32x16 (&o)[2], LAS float* wsf, int lane) {
    const int q = lane & 31, hi = lane >> 5;
    asm volatile("s_nop 15" : "+v"(p0), "+v"(p1), "+v"(p2), "+v"(p3));
    float a = max3f(p0[0], p0[1], p0[2]), b = max3f(p1[0], p1[1], p1[2]), c = max3f(p2[0], p2[1], p2[2]), d = max3f(p3[0], p3[1], p3[2]);
#pragma unroll
    for (int r = 3; r < 15; r += 2) { a = max3f(a, p0[r], p0[r + 1]); b = max3f(b, p1[r], p1[r + 1]); c = max3f(c, p2[r], p2[r + 1]); d = max3f(d, p3[r], p3[r + 1]); }
    a = max3f(a, p0[15], p1[15]); c = max3f(c, p2[15], p3[15]);
    float mt = max3f(a, b, c); mt = max3f(mt, d, d);
    mt = xhalf_max(mt);
    if (first || __any(mt > RESC_THR)) {
        const float delta = first ? ((mt > -1.0e29f) ? mt : 0.f) : fmaxf(mt, 0.f);
        m_run += delta;
#pragma unroll
        for (int r = 0; r < 16; ++r) { p0[r] -= delta; p1[r] -= delta; p2[r] -= delta; p3[r] -= delta; cm[r] = -m_run; }
        if (!first) {
            const float alpha = __builtin_amdgcn_exp2f(-delta);
            if (hi == 0) wsf[q] = alpha;
            asm volatile("s_waitcnt lgkmcnt(0)" ::: "memory");
#pragma unroll
            for (int r4 = 0; r4 < 4; ++r4) { const f32x4 a4 = *(const LAS f32x4*)(wsf + 8 * r4 + 4 * hi);
#pragma unroll
                for (int j = 0; j < 4; ++j) { o[0][4 * r4 + j] *= a4[j]; o[1][4 * r4 + j] *= a4[j]; lacc[4 * r4 + j] *= a4[j]; } }
            asm volatile("" ::: "memory");
        }
    }
#pragma unroll
    for (int r = 0; r < 16; ++r) { p0[r] = __builtin_amdgcn_exp2f(p0[r]); p1[r] = __builtin_amdgcn_exp2f(p1[r]); p2[r] = __builtin_amdgcn_exp2f(p2[r]); p3[r] = __builtin_amdgcn_exp2f(p3[r]); }
}
__device__ __forceinline__ int stage_next(int cs) { const int ks = cs & 1, vs = cs >> 1; return (ks ^ 1) + 2 * (vs == 2 ? 0 : vs + 1); }
template <class CinitF, class PostF, class TailF>
__device__ __forceinline__ int attn_stream(LAS unsigned char* lds, const bf16_t* Kp, const bf16_t* Vp, long row0, int g, int nt, int tid, int lane, const bf16x8 (&qr)[4], LAS float* wsf,
                                           f32x16 (&o)[2], float& m_run, f32x16& lacc, const CinitF& cinit, const PostF& post, int cs, bool late, const TailF& tail) {
    const int q = lane & 31, hi = lane >> 5;
    const int np = (nt + 1) >> 1;
    f32x16 cm;
#pragma unroll
    for (int r = 0; r < 16; ++r) { cm[r] = 0.f; lacc[r] = 0.f; }
    bf16x8 ones = (bf16x8){(short)0x3F80, (short)0x3F80, (short)0x3F80, (short)0x3F80, (short)0x3F80, (short)0x3F80, (short)0x3F80, (short)0x3F80}; asm volatile("" : "+v"(ones));
    for (int p = 0; p < np; ++p) {
        const int t0 = 2 * p; const bool two = t0 + 1 < nt;
        const int kst = (cs & 1) * 2, vst = (cs >> 1) * 2, cn = stage_next(cs);
        if (p + 1 < np) { kv_dma(lds, (cn & 1) * 2, (cn >> 1) * 2, Kp, Vp, row0 + 64 * (t0 + 2), g, tid); if (t0 + 3 < nt) kv_dma(lds, (cn & 1) * 2 + 1, (cn >> 1) * 2 + 1, Kp, Vp, row0 + 64 * (t0 + 3), g, tid); }
        else tail(cn);
        f32x16 s0_, s1, s2, s3;
        { const f32x16 ci = cinit(t0, cm); qk_tile_c(lds + AT_K + kst * 8192, qr, q, hi, ci, s0_, s1); post(t0, s0_, s1); }
        if (two) { const f32x16 ci = cinit(t0 + 1, cm); qk_tile_c(lds + AT_K + (kst + 1) * 8192, qr, q, hi, ci, s2, s3); post(t0 + 1, s2, s3); }
        else {
#pragma unroll
            for (int r = 0; r < 16; ++r) { s2[r] = MASKV; s3[r] = MASKV; }
        }
        softmax_rel2(s0_, s1, s2, s3, p == 0, m_run, cm, lacc, o, wsf, lane);
        if (!late) { pv_tile_l<true>(lds + AT_V + vst * 8192, lane, s0_, s1, o, lacc, ones); if (two) pv_tile_l<true>(lds + AT_V + (vst + 1) * 8192, lane, s2, s3, o, lacc, ones); }
        asm volatile("s_waitcnt vmcnt(0) lgkmcnt(0)" ::: "memory");
        __builtin_amdgcn_s_barrier(); asm volatile("" ::: "memory");
        if (late) { pv_tile_l<true>(lds + AT_V + vst * 8192, lane, s0_, s1, o, lacc, ones); if (two) pv_tile_l<true>(lds + AT_V + (vst + 1) * 8192, lane, s2, s3, o, lacc, ones); }
        cs = cn;
    }
#pragma unroll
    for (int r = 0; r < 16; ++r) { const float rl = __builtin_amdgcn_rcpf(lacc[r]); o[0][r] *= rl; o[1][r] *= rl; }
    return cs;
}
#define A2_SBAR() __builtin_amdgcn_sched_barrier(0)
#define A2_PIN(x) asm volatile("" : "+v"(x))
#define A2_MFMA(a, b, c) __builtin_amdgcn_mfma_f32_32x32x16_bf16(a, b, c, 0, 0, 0)
template <bool SEL, class PostF>
__device__ __forceinline__ float attn_stream2(LAS unsigned char* lds, const bf16_t* Kp, const bf16_t* Vp, long row0, int g, int nt, int tid, int lane, const bf16x8 (&qr)[4], LAS float* wsf,
                                             f32x16 (&o)[2], unsigned mysel, const PostF& post) {
    const int r32 = lane & 31, hi = lane >> 5; const int wid = __builtin_amdgcn_readfirstlane(tid >> 6);
    const int key = 8 * wid + (lane >> 3), s16 = lane & 7;
    const bf16_t* ksrc = Kp + (row0 + key) * 256 + g * 64 + k_src_chunk(key, s16) * 8;
    const bf16_t* vsrc = Vp + (row0 + key) * 256 + g * 64 + v_src_chunk(key, s16) * 8;
    const unsigned l0 = (unsigned)(size_t)lds, kdst = l0 + AT_K + wid * 1024, vdst = l0 + AT_V + wid * 1024;
#define A2_DMA_K(t_, so_) glds16(ksrc + (long)(t_) * 64 * 256, (unsigned)__builtin_amdgcn_readfirstlane(kdst + (so_)))
#define A2_DMA_V(t_, so_) glds16(vsrc + (long)(t_) * 64 * 256, (unsigned)__builtin_amdgcn_readfirstlane(vdst + (so_)))
    int kb[4];
#pragma unroll
    for (int d0 = 0; d0 < 4; ++d0) kb[d0] = AT_K + k_frag_off(r32, 2 * d0 + hi);
    const int qp = (lane & 15) >> 2, sw = (qp >> 1) & 1;
    const int vb = AT_V + (4 * hi + qp) * 128 + ((lane >> 4) & 1) * 32 + (lane & 3) * 8, vba = vb + (sw << 6), vbb = vb + ((sw ^ 1) << 6);
    constexpr int SLOTB = 8192;
    A2_DMA_K(0, 0); A2_DMA_V(0, 0); if (nt > 1) A2_DMA_K(1, SLOTB); if (nt > 2) A2_DMA_K(2, 2 * SLOTB);
    float mhat = 0.f, l_reg = 0.f;
#pragma unroll
    for (int r = 0; r < 16; ++r) { o[0][r] = 0.f; o[1][r] = 0.f; }
    f32x16 cm;
#pragma unroll
    for (int r = 0; r < 16; ++r) cm[r] = 0.f;
    A2_PIN(cm);
    f32x16 pA0, pA1, pB0, pB1; bf16x8 kf[8]; v4i16_t vlo[8], vhi[8]; u32x4 pw0, pw1, pw2, pw3; bool resc = false;
    int sl_prev = 0, sl_cur = 0, sl_next = SLOTB;
#define A2_ROT() do { sl_prev = sl_cur; sl_cur = sl_next; sl_next = (sl_next == 2 * SLOTB) ? 0 : sl_next + SLOTB; } while (0)
#define A2_KLD2(d0_, so_) do { kf[2 * (d0_)] = *(const LAS bf16x8*)(lds + kb[d0_] + (so_)); kf[2 * (d0_) + 1] = *(const LAS bf16x8*)(lds + kb[d0_] + (so_) + 4096); } while (0)
#define A2_CI(t_, CI) do { const bool s_ = !SEL || ((mysel >> (t_)) & 1u) != 0u; _Pragma("unroll") for (int r = 0; r < 16; ++r) CI[r] = s_ ? cm[r] : MASKV; } while (0)
#define A2_RESC() do { if (resc) { asm volatile("s_waitcnt lgkmcnt(0)" ::: "memory"); _Pragma("unroll") for (int r4 = 0; r4 < 4; ++r4) { const f32x4 a4 = *(const LAS f32x4*)(wsf + 8 * r4 + 4 * hi); \
        _Pragma("unroll") for (int j = 0; j < 4; ++j) { o[0][4 * r4 + j] *= a4[j]; o[1][4 * r4 + j] *= a4[j]; } } } } while (0)
    asm volatile("s_waitcnt vmcnt(0)" ::: "memory"); __builtin_amdgcn_s_barrier(); asm volatile("" ::: "memory");
    { f32x16 ci; A2_CI(0, ci); qk_tile_c(lds + AT_K, qr, r32, hi, ci, pA0, pA1); post(0, pA0, pA1);
      asm volatile("s_nop 15" : "+v"(pA0), "+v"(pA1));
      float a = max3f(pA0[0], pA0[1], pA0[2]), b2 = max3f(pA1[0], pA1[1], pA1[2]);
#pragma unroll
      for (int r = 3; r < 15; r += 2) { a = max3f(a, pA0[r], pA0[r + 1]); b2 = max3f(b2, pA1[r], pA1[r + 1]); }
      float rm = max3f(a, b2, pA0[15]); rm = max3f(rm, pA1[15], pA1[15]); rm = xhalf_max(rm);
      const float dl = (rm > -1.0e29f) ? rm : 0.f; mhat = dl;
#pragma unroll
      for (int r = 0; r < 16; ++r) { pA0[r] = __builtin_amdgcn_exp2f(pA0[r] - dl); pA1[r] = __builtin_amdgcn_exp2f(pA1[r] - dl); cm[r] = -mhat; }
      A2_PIN(cm); }
    if (nt > 1) {
#pragma unroll
        for (int d0 = 0; d0 < 4; ++d0) A2_KLD2(d0, SLOTB);
    }
    asm volatile("s_waitcnt lgkmcnt(0)" ::: "memory"); __builtin_amdgcn_s_barrier(); asm volatile("" ::: "memory");
    if (nt > 3) A2_DMA_K(3, 0);
    if (nt > 1) A2_DMA_V(1, SLOTB);
    A2_ROT();
#define A2_PKW(P, i) pk2(P[i], P[i + 1])
#define A2_PAF(k_) __builtin_bit_cast(bf16x8, pw##k_)
#define A2_VFR(i) (bf16x8){vlo[i][0], vlo[i][1], vlo[i][2], vlo[i][3], vhi[i][0], vhi[i][1], vhi[i][2], vhi[i][3]}
#define A2_VRD(i) do { const LAS unsigned char* p_ = lds + (((i) >> 2) ? vbb : vba) + sl_prev + ((i) & 3) * 2048; vlo[i] = __builtin_amdgcn_ds_read_tr16_b64_v4i16((LAS v4i16_t*)p_); vhi[i] = __builtin_amdgcn_ds_read_tr16_b64_v4i16((LAS v4i16_t*)(p_ + 1024)); } while (0)
#define A2_KRD(G_, d0_) do { if (G_) { A2_KLD2(d0_, sl_next); A2_SBAR(); } } while (0)
#define A2_GAPA(MF, a0, a1, a2, a3, W0, W1, PW) do { MF; sacc += a0; sacc += a1; sacc += a2; sacc += a3; A2_PIN(sacc); W0; W1; A2_PIN(PW); A2_SBAR(); } while (0)
#define A2_GAPB(MF, X, i) do { MF; X[i] = __builtin_amdgcn_exp2f(X[i]); X[i + 1] = __builtin_amdgcn_exp2f(X[i + 1]); X[i + 2] = __builtin_amdgcn_exp2f(X[i + 2]); X[i + 3] = __builtin_amdgcn_exp2f(X[i + 3]); A2_PIN(X); A2_SBAR(); } while (0)
#define A2_STEP(C0, C1, P0, P1, t_) do { const int tt_ = (t_); const bool GK_ = tt_ + 3 < nt, GV_ = tt_ + 1 < nt; \
    f32x16 ci_; if (SEL) { A2_CI(tt_, ci_); A2_PIN(ci_); } A2_SBAR(); \
    A2_VRD(0); A2_SBAR(); float sacc = P0[0] + P0[1]; \
                       A2_GAPA(C0 = A2_MFMA(kf[0], qr[0], SEL ? ci_ : cm), P0[2], P0[3], P0[4], P0[5],     pw0[0] = A2_PKW(P0, 0),  pw0[1] = A2_PKW(P0, 2),  pw0); \
    A2_VRD(4); A2_SBAR(); A2_GAPA(C1 = A2_MFMA(kf[1], qr[0], SEL ? ci_ : cm), P0[6], P0[7], P0[8], P0[9],     pw0[2] = A2_PKW(P0, 4),  pw0[3] = A2_PKW(P0, 6),  pw0); \
    A2_VRD(1); A2_SBAR(); A2_GAPA(C0 = A2_MFMA(kf[2], qr[1], C0),  P0[10], P0[11], P0[12], P0[13], pw1[0] = A2_PKW(P0, 8),  pw1[1] = A2_PKW(P0, 10), pw1); \
    A2_VRD(5); A2_SBAR(); A2_GAPA(C1 = A2_MFMA(kf[3], qr[1], C1),  P0[14], P0[15], P1[0], P1[1],   pw1[2] = A2_PKW(P0, 12), pw1[3] = A2_PKW(P0, 14), pw1); \
    A2_VRD(2); A2_SBAR(); A2_GAPA(C0 = A2_MFMA(kf[4], qr[2], C0),  P1[2], P1[3], P1[4], P1[5],     pw2[0] = A2_PKW(P1, 0),  pw2[1] = A2_PKW(P1, 2),  pw2); \
    A2_VRD(6); A2_SBAR(); A2_GAPA(C1 = A2_MFMA(kf[5], qr[2], C1),  P1[6], P1[7], P1[8], P1[9],     pw2[2] = A2_PKW(P1, 4),  pw2[3] = A2_PKW(P1, 6),  pw2); \
    A2_VRD(3); A2_SBAR(); A2_GAPA(C0 = A2_MFMA(kf[6], qr[3], C0),  P1[10], P1[11], P1[12], P1[13], pw3[0] = A2_PKW(P1, 8),  pw3[1] = A2_PKW(P1, 10), pw3); \
    A2_VRD(7); A2_SBAR(); A2_GAPA(C1 = A2_MFMA(kf[7], qr[3], C1),  P1[14], P1[15], 0.f, 0.f,       pw3[2] = A2_PKW(P1, 12), pw3[3] = A2_PKW(P1, 14), pw3); \
    l_reg += sacc; \
    if (GK_) A2_DMA_K(tt_ + 3, sl_cur); if (GV_) A2_DMA_V(tt_ + 1, sl_next); \
    post(tt_, C0, C1); \
    { asm volatile("s_nop 15" : "+v"(C0), "+v"(C1)); \
      float a_ = max3f(C0[0], C0[1], C0[2]), b_ = max3f(C1[0], C1[1], C1[2]); \
      _Pragma("unroll") for (int r = 3; r < 15; r += 2) { a_ = max3f(a_, C0[r], C0[r + 1]); b_ = max3f(b_, C1[r], C1[r + 1]); } \
      float rm_ = max3f(a_, b_, C0[15]); rm_ = max3f(rm_, C1[15], C1[15]); rm_ = xhalf_max(rm_); resc = false; \
      if (__builtin_expect(__any(rm_ > RESC_THR), 0)) { const float dl_ = fmaxf(rm_, 0.f); mhat += dl_; \
          _Pragma("unroll") for (int r = 0; r < 16; ++r) { C0[r] -= dl_; C1[r] -= dl_; cm[r] = -mhat; } A2_PIN(cm); \
          const float f_ = __builtin_amdgcn_exp2f(-dl_); l_reg *= f_; if (hi == 0) wsf[r32] = f_; resc = true; } } \
    A2_SBAR(); \
    A2_GAPB(o[0] = A2_MFMA(A2_PAF(0), A2_VFR(0), o[0]), C0, 0);               A2_GAPB(o[1] = A2_MFMA(A2_PAF(0), A2_VFR(4), o[1]), C0, 4); \
    A2_KRD(GV_, 0); A2_GAPB(o[0] = A2_MFMA(A2_PAF(1), A2_VFR(1), o[0]), C0, 8);  A2_KRD(GV_, 1); A2_GAPB(o[1] = A2_MFMA(A2_PAF(1), A2_VFR(5), o[1]), C0, 12); \
    A2_KRD(GV_, 2); A2_GAPB(o[0] = A2_MFMA(A2_PAF(2), A2_VFR(2), o[0]), C1, 0);  A2_KRD(GV_, 3); A2_GAPB(o[1] = A2_MFMA(A2_PAF(2), A2_VFR(6), o[1]), C1, 4); \
    A2_GAPB(o[0] = A2_MFMA(A2_PAF(3), A2_VFR(3), o[0]), C1, 8);               A2_GAPB(o[1] = A2_MFMA(A2_PAF(3), A2_VFR(7), o[1]), C1, 12); \
    if (GK_ && GV_) asm volatile("s_waitcnt vmcnt(2) lgkmcnt(0)\n\ts_barrier" ::: "memory"); else if (GV_) asm volatile("s_waitcnt vmcnt(1) lgkmcnt(0)\n\ts_barrier" ::: "memory"); else asm volatile("s_waitcnt vmcnt(0) lgkmcnt(0)\n\ts_barrier" ::: "memory"); \
    A2_RESC(); A2_ROT(); } while (0)
#define A2_DRAIN(P0, P1) do { float sacc = P0[0] + P0[1]; \
      _Pragma("unroll") for (int r = 2; r < 16; ++r) sacc += P0[r]; \
      _Pragma("unroll") for (int r = 0; r < 16; ++r) sacc += P1[r]; \
      l_reg += sacc; \
      pw0 = (u32x4){A2_PKW(P0, 0), A2_PKW(P0, 2), A2_PKW(P0, 4), A2_PKW(P0, 6)}; pw1 = (u32x4){A2_PKW(P0, 8), A2_PKW(P0, 10), A2_PKW(P0, 12), A2_PKW(P0, 14)}; \
      pw2 = (u32x4){A2_PKW(P1, 0), A2_PKW(P1, 2), A2_PKW(P1, 4), A2_PKW(P1, 6)}; pw3 = (u32x4){A2_PKW(P1, 8), A2_PKW(P1, 10), A2_PKW(P1, 12), A2_PKW(P1, 14)}; \
      _Pragma("unroll") for (int i = 0; i < 8; ++i) A2_VRD(i); \
      o[0] = A2_MFMA(A2_PAF(0), A2_VFR(0), o[0]); o[1] = A2_MFMA(A2_PAF(0), A2_VFR(4), o[1]); o[0] = A2_MFMA(A2_PAF(1), A2_VFR(1), o[0]); o[1] = A2_MFMA(A2_PAF(1), A2_VFR(5), o[1]); \
      o[0] = A2_MFMA(A2_PAF(2), A2_VFR(2), o[0]); o[1] = A2_MFMA(A2_PAF(2), A2_VFR(6), o[1]); o[0] = A2_MFMA(A2_PAF(3), A2_VFR(3), o[0]); o[1] = A2_MFMA(A2_PAF(3), A2_VFR(7), o[1]); } while (0)
    int t = 1;
#pragma unroll 1
    for (; t + 1 < nt; t += 2) { A2_STEP(pB0, pB1, pA0, pA1, t); A2_STEP(pA0, pA1, pB0, pB1, t + 1); }
    if (t < nt) { A2_STEP(pB0, pB1, pA0, pA1, t); A2_DRAIN(pB0, pB1); } else { A2_DRAIN(pA0, pA1); }
    asm volatile("s_waitcnt lgkmcnt(0)" ::: "memory"); __builtin_amdgcn_s_barrier(); asm volatile("" ::: "memory");
#undef A2_DMA_K
#undef A2_DMA_V
#undef A2_ROT
#undef A2_KLD2
#undef A2_CI
#undef A2_RESC
#undef A2_PKW
#undef A2_PAF
#undef A2_VFR
#undef A2_VRD
#undef A2_KRD
#undef A2_GAPA
#undef A2_GAPB
#undef A2_STEP
#undef A2_DRAIN
    return xhalf_sum(l_reg);
}
__device__ __forceinline__ void acc_scaled(LAS float* oaccL, const f32x16 (&o)[2], float f, LAS float* wsf, int lane, bool init) {
    const int q = lane & 31, hi = lane >> 5;
    if (hi == 0) wsf[32 + q] = f;
    asm volatile("s_waitcnt lgkmcnt(0)" ::: "memory");
#pragma unroll
    for (int r4 = 0; r4 < 4; ++r4) { const f32x4 a4 = *(const LAS f32x4*)(wsf + 32 + 8 * r4 + 4 * hi);
#pragma unroll
        for (int j = 0; j < 4; ++j) { const int r = 4 * r4 + j; LAS float* p0 = oaccL + r * 64 + lane; LAS float* p1 = oaccL + (16 + r) * 64 + lane;
            if (init) { *p0 = a4[j] * o[0][r]; *p1 = a4[j] * o[1][r]; } else { *p0 += a4[j] * o[0][r]; *p1 += a4[j] * o[1][r]; } } }
    asm volatile("s_waitcnt lgkmcnt(0)" ::: "memory");
}

__device__ __forceinline__ void acc_final_store(LAS float* oaccL, const f32x16 (&o)[2], float f, LAS float* wsf, int lane, bf16_t* Ow, bool wt) {
    const int q = lane & 31, hi = lane >> 5;
    if (hi == 0) wsf[32 + q] = f;
    asm volatile("s_waitcnt lgkmcnt(0)" ::: "memory");
    f32x16 r0, r1;
#pragma unroll
    for (int r4 = 0; r4 < 4; ++r4) { const f32x4 a4 = *(const LAS f32x4*)(wsf + 32 + 8 * r4 + 4 * hi);
#pragma unroll
        for (int j = 0; j < 4; ++j) { const int r = 4 * r4 + j; r0[r] = oaccL[r * 64 + lane] + a4[j] * o[0][r]; r1[r] = oaccL[(16 + r) * 64 + lane] + a4[j] * o[1][r]; } }
    asm volatile("s_waitcnt lgkmcnt(0)" ::: "memory");
    LAS bf16_t* stg = (LAS bf16_t*)oaccL;
#pragma unroll
    for (int r = 0; r < 16; ++r) { const int orow = crow(r, hi); stg[orow * 64 + q] = (bf16_t)f2bf(r0[r]); stg[orow * 64 + 32 + q] = (bf16_t)f2bf(r1[r]); }
    asm volatile("s_waitcnt lgkmcnt(0)" ::: "memory");
#pragma unroll
    for (int i = 0; i < 4; ++i) { const int row = i * 8 + (lane >> 3), ch = lane & 7; const u32x4 v = *(const LAS u32x4*)(stg + row * 64 + ch * 8); if (wt) store16_wt(Ow + (long)row * 1024 + ch * 8, v); else *(u32x4*)(Ow + (long)row * 1024 + ch * 8) = v; }
    asm volatile("s_waitcnt lgkmcnt(0)" ::: "memory");
}

typedef int i32x4 __attribute__((ext_vector_type(4)));
__device__ __forceinline__ void cnt_gt(int& cnt, int a, int b) { asm("v_cmp_gt_i32_e32 vcc, %1, %2\n\tv_addc_co_u32_e32 %0, vcc, 0, %0, vcc" : "+v"(cnt) : "v"(a), "v"(b) : "vcc"); }
__device__ __forceinline__ int attn_item(Frame& F, const AttnPtrs& P, int b, int g, int qt, int cs, int nb_, int ng_, int prev_pm, int mode = 0) {
    LAS unsigned char* lds = F.lds;
    int tid = threadIdx.x; asm volatile("" : "+v"(tid)); int lane = tid & 63; const int w = __builtin_amdgcn_readfirstlane(tid >> 6), hd = w & 3, sb = w >> 2; int q = lane & 31, hi = lane >> 5;
    const int t0 = qt * 64, ql = 32 * sb + q, tq = t0 + ql;
#define RELAUNDER() do { tid = threadIdx.x; asm volatile("" : "+v"(tid)); lane = tid & 63; q = lane & 31; hi = lane >> 5; } while (0)
    const long rowq = (long)b * S + tq;
    const int head = g * 4 + hd;
    LAS float* wsf = (LAS float*)(lds + AT_WSF) + w * 64;
    LAS float* Psum = (LAS float*)(lds + AT_PSUM);
    LAS float* scr = (LAS float*)(lds + AT_SCR);
    LAS unsigned* selm = (LAS unsigned*)(lds + AT_SELM);
    bf16x8 qr[4];
#pragma unroll
    for (int d0 = 0; d0 < 4; ++d0) qr[d0] = *(const bf16x8*)(P.Q + rowq * 1024 + head * 64 + d0 * 16 + hi * 8);
    LAS float* oaccL = (LAS float*)(lds + AT_OACC) + w * 2048;
    const float* ngp = P.NG + ((long)b * S + t0 + 32 * sb + q) * 48 + head; const float g_cmp = ngp[0], g_sel = ngp[16], g_win = ngp[32];
    const int wkt0 = qt >= 8 ? qt - 8 : 0, wnt = qt - wkt0 + 1;
    const LAS unsigned char* cK = lds + AT_K; const LAS unsigned char* cV = lds + AT_V;
    {
        RELAUNDER();
        kv_dma(lds, 0, 0, P.KC, P.VC, (long)b * 128, g, tid); kv_dma(lds, 1, 1, P.KC, P.VC, (long)b * 128 + 64, g, tid);
        asm volatile("s_waitcnt vmcnt(0)" ::: "memory"); __builtin_amdgcn_s_barrier(); asm volatile("" ::: "memory");
        if (P.ordy && prev_pm >= 0 && tid == 0) __hip_atomic_fetch_add(P.ordy + 4 * prev_pm, 1u, __ATOMIC_RELAXED, __HIP_MEMORY_SCOPE_AGENT);
        const int nlim0 = min((tq - 31) >> 4, 126);
#define CMP_MASK(kt_, P0, P1) do { int nl_ = nlim0 - 64 * (kt_); asm volatile("" : "+v"(nl_)); _Pragma("unroll") for (int r = 0; r < 16; ++r) { const int n = crow(r, hi); \
            P0[r] = (n <= nl_) ? P0[r] : MASKV; P1[r] = (n + 32 <= nl_) ? P1[r] : MASKV; } } while (0)
        f32x16 p0, p1, p2, p3;
        qk_tile(cK, qr, q, hi, p0, p1); CMP_MASK(0, p0, p1);
        qk_tile(cK + 8192, qr, q, hi, p2, p3); CMP_MASK(1, p2, p3);
#undef CMP_MASK
        float mt = fmaxf(fmaxf(p0[0], p1[0]), fmaxf(p2[0], p3[0]));
#pragma unroll
        for (int r = 1; r < 16; ++r) mt = fmaxf(fmaxf(mt, fmaxf(p0[r], p1[r])), fmaxf(p2[r], p3[r]));
        mt = xhalf_max(mt);
        float sum = 0.f;
#pragma unroll
        for (int r = 0; r < 16; ++r) { p0[r] = __builtin_amdgcn_exp2f(p0[r] - mt); p1[r] = __builtin_amdgcn_exp2f(p1[r] - mt); p2[r] = __builtin_amdgcn_exp2f(p2[r] - mt); p3[r] = __builtin_amdgcn_exp2f(p3[r] - mt);
            sum += (p0[r] + p1[r]) + (p2[r] + p3[r]); }
        sum = xhalf_sum(sum);
        const float rl = (tq >= 31) ? 1.0f / sum : 0.f;
#pragma unroll
        for (int r = 0; r < 16; ++r) { p0[r] *= rl; p1[r] *= rl; p2[r] *= rl; p3[r] *= rl; }
        const bool selall = qt < 16;
        if (!selall) {
            float lastv[16], fromA[16], fromB[16];
#pragma unroll
            for (int j = 0; j < 4; ++j)
#pragma unroll
                for (int i = 0; i < 4; ++i) { const float xl = (j == 0) ? p0[4 * i + 3] : (j == 1) ? p1[4 * i + 3] : (j == 2) ? p2[4 * i + 3] : p3[4 * i + 3];
                    lastv[4 * j + i] = xl; float a = xl, b2 = xl; swap32(a, b2); fromA[4 * j + i] = a; fromB[4 * j + i] = b2; }
            LAS float* ph = Psum + hd * (64 * 33) + ql * 33;
#pragma unroll
            for (int j = 0; j < 4; ++j)
#pragma unroll
                for (int i = 0; i < 4; ++i) { const int e = 4 * j + i;
                    const float q0 = (j == 0) ? p0[4 * i] : (j == 1) ? p1[4 * i] : (j == 2) ? p2[4 * i] : p3[4 * i];
                    const float q1 = (j == 0) ? p0[4 * i + 1] : (j == 1) ? p1[4 * i + 1] : (j == 2) ? p2[4 * i + 1] : p3[4 * i + 1];
                    const float q2 = (j == 0) ? p0[4 * i + 2] : (j == 1) ? p1[4 * i + 2] : (j == 2) ? p2[4 * i + 2] : p3[4 * i + 2];
                    const float prevLo = (e == 0) ? 0.f : fromB[e - 1];
                    const float prev = hi ? fromA[e] : prevLo;
                    ph[2 * i + hi + 8 * j] = (q0 + q1) + (q2 + 0.5f * lastv[e]) + 0.5f * prev; }
        }
        __syncthreads();
        f32x16 o[2];
#pragma unroll
        for (int r = 0; r < 16; ++r) { o[0][r] = 0.f; o[1][r] = 0.f; }
        pv_tile(cV, lane, p0, p1, o); pv_tile(cV + 8192, lane, p2, p3, o);
        if (selall) { if (tid < 64) selm[tid] = (2u << qt) - 1u; }
        else {
            const int tk = tid >> 3, mg = tid & 7;
            const LAS float* pr = Psum + tk * 33;
            float sc4[4];
#pragma unroll
            for (int j = 0; j < 4; ++j) {
                const int m = 4 * mg + j;
                const float ps = (pr[m] + pr[64 * 33 + m]) + (pr[2 * 64 * 33 + m] + pr[3 * 64 * 33 + m]);
                const bool allowed = m <= qt, forced = (m == 0) || (m == qt) || (m == qt - 1);
                sc4[j] = allowed ? (ps + (forced ? 1.0e4f : 0.f)) : -1.0f;
                scr[tk * 32 + m] = sc4[j];
            }
            __syncthreads();
            int key4[4], rank[4];
#pragma unroll
            for (int j = 0; j < 4; ++j) { key4[j] = __builtin_bit_cast(int, sc4[j]); rank[j] = 0; }
            const LAS i32x4* kp = (const LAS i32x4*)(scr + tk * 32);
#pragma unroll
            for (int g2 = 0; g2 < 8; ++g2) {
                const i32x4 kv = kp[g2]; const int adj = (g2 < mg) ? 1 : 0;
#pragma unroll
                for (int j = 0; j < 4; ++j) { const int thr = key4[j] - adj;
#pragma unroll
                    for (int j2 = 0; j2 < 4; ++j2) cnt_gt(rank[j], kv[j2], thr); }
            }
            rank[1] += (key4[0] == key4[1]) ? 1 : 0;
            rank[2] += ((key4[0] == key4[2]) ? 1 : 0) + ((key4[1] == key4[2]) ? 1 : 0);
            rank[3] += ((key4[0] == key4[3]) ? 1 : 0) + ((key4[1] == key4[3]) ? 1 : 0) + ((key4[2] == key4[3]) ? 1 : 0);
            unsigned bits = 0u;
#pragma unroll
            for (int j = 0; j < 4; ++j) { const int m = 4 * mg + j; if (rank[j] < 16 && m <= qt) bits |= 1u << m; }
            bits |= swz_xor<1>(bits); bits |= swz_xor<2>(bits); bits |= swz_xor<4>(bits);
            if (mg == 0) selm[tk] = bits;
        }
        __syncthreads();
        acc_scaled(oaccL, o, g_cmp, wsf, lane, true);
    }
    const unsigned mysel = selm[ql];
    {
        RELAUNDER();
        const int kt0 = wkt0, nt = wnt;
        f32x16 o[2];
        auto post = [&](int it, f32x16& p0, f32x16& p1) {
            if (it == 0 || it == nt - 1) {
                int dq = tq - 64 * (kt0 + it); asm volatile("" : "+v"(dq));
#pragma unroll
                for (int r = 0; r < 16; ++r) { const int x0 = dq - crow(r, hi), x1 = x0 - 32;
                    p0[r] = mask_neg(p0[r], x0 | (511 - x0)); p1[r] = mask_neg(p1[r], x1 | (511 - x1)); }
            }
        };
        float lt = 1.f;
#pragma unroll
        for (int r = 0; r < 16; ++r) { o[0][r] = 0.f; o[1][r] = 0.f; }
        if (!(mode & 1)) lt = attn_stream2<false>(lds, P.KW, P.VW, (long)b * S + 64 * kt0, g, nt, tid, lane, qr, wsf, o, 0u, post);
        acc_scaled(oaccL, o, g_win / lt, wsf, lane, false);
    }
    {
        RELAUNDER();
        const int nt = qt + 1;
        f32x16 o[2];
        auto post = [&](int kt, f32x16& p0, f32x16& p1) {
            if (kt == qt) {
                int qlim = ql; asm volatile("" : "+v"(qlim));
#pragma unroll
                for (int r = 0; r < 16; ++r) { const int kl = crow(r, hi); p0[r] = mask_neg(p0[r], qlim - kl); p1[r] = mask_neg(p1[r], qlim - kl - 32); }
            }
        };
        float lt = 1.f;
#pragma unroll
        for (int r = 0; r < 16; ++r) { o[0][r] = 0.f; o[1][r] = 0.f; }
        if (!(mode & 2)) lt = attn_stream2<true>(lds, P.KS, P.VS, (long)b * S, g, nt, tid, lane, qr, wsf, o, mysel, post);
        RELAUNDER();
        acc_final_store(oaccL, o, g_sel / lt, wsf, lane, P.O + ((long)b * S + t0 + 32 * sb) * 1024 + head * 64, P.ordy != nullptr);
    }
    asm volatile("s_waitcnt lgkmcnt(0)" ::: "memory"); __builtin_amdgcn_s_barrier(); asm volatile("" ::: "memory");
    return 0;
#undef RELAUNDER
}
__device__ __forceinline__ void attn_phase(Frame& F, const AttnPtrs& P, int mode = 0) {
    const int vcu = (F.G % 8 == 0) ? (F.bid % 8) * (F.G / 8) + F.bid / 8 : F.bid;
    const int pr0 = vcu >> 3, prs = F.G >> 3, npr = P.nb * 4;
    int cs = 0, prev_pm = -1;
    for (int pr = pr0; pr < npr; pr += prs) {
        const int b = pr >> 2, g = pr & 3, s8 = vcu & 7;
        if (P.ready) {
            if (threadIdx.x < 64) {
                unsigned sp = 0;
                while ((unsigned)__builtin_amdgcn_readfirstlane(__hip_atomic_load(P.ready + 8 * pr, __ATOMIC_RELAXED, __HIP_MEMORY_SCOPE_AGENT)) < 8u) { __builtin_amdgcn_s_sleep(2); if (++sp > (1u << 22)) break; }
                __builtin_amdgcn_fence(__ATOMIC_ACQUIRE, "agent");
            }
            __syncthreads();
        }
        for (int i = 0; i < 4; ++i) { const int qt = (i == 0) ? s8 : (i == 1) ? 15 - s8 : (i == 2) ? 16 + s8 : 31 - s8;
            const int npr_ = (i < 3) ? pr : pr + prs; const int nb_ = (npr_ < npr) ? (npr_ >> 2) : -1, ng_ = npr_ & 3;
            cs = attn_item(F, P, b, g, qt, cs, nb_, ng_, prev_pm, mode); prev_pm = b * 8 + (qt >> 2); }
    }
    __syncthreads();
    if (P.ordy && prev_pm >= 0 && threadIdx.x == 0) __hip_atomic_fetch_add(P.ordy + 4 * prev_pm, 1u, __ATOMIC_RELAXED, __HIP_MEMORY_SCOPE_AGENT);
}
struct LruPtrs { const bf16_t* XR; const bf16_t* GG; bf16_t* GAo; const float *cw, *cb, *ba, *bi, *lam; const bf16_t *WaT, *WiT; float* AGG; int nb; unsigned* ready; };
constexpr int LR_XS = 0, LR_XC = 33792, LR_XCS = 68  , LR_A = LR_XC + 128 * LR_XCS * 4, LR_SEG = LR_A + 32768, LR_CIN = LR_SEG + 4096, LR_END = LR_CIN + 256;
static_assert(LR_END <= STAGE_BYTES, "lru LDS map");
__device__ __forceinline__ float fast_sigmoid(float x) { return __builtin_amdgcn_rcpf(1.0f + __builtin_amdgcn_exp2f(-1.4426950408889634f * x)); }
template <int PASS>
__device__ __forceinline__ void lru_item(Frame& F, const LruPtrs& P, int b, int hb, int ch) {
    LAS unsigned char* lds = F.lds;
    int tid = threadIdx.x; asm volatile("" : "+v"(tid));
    const int lane = tid & 63, w = __builtin_amdgcn_readfirstlane(tid >> 6);
    LAS float* xs = (LAS float*)(lds + LR_XS); LAS float* xc = (LAS float*)(lds + LR_XC); LAS float* ab = (LAS float*)(lds + LR_A);
    LAS float* segA = (LAS float*)(lds + LR_SEG); LAS float* segH = segA + 512; LAS float* cin = (LAS float*)(lds + LR_CIN);
    const int c0 = ch * 128; const long rowb = (long)b * S;
    for (int i = tid; i < 131 * 8; i += 512) {
        const int row = i >> 3, c8 = i & 7, t = c0 - 3 + row;
        u32x4 v = (u32x4){0u, 0u, 0u, 0u};
        if (t >= 0) v = *(const u32x4*)(P.XR + (rowb + t) * 1024 + hb * 64 + c8 * 8);
        f32x4 lo, hi4;
        lo[0] = __builtin_bit_cast(float, v.x << 16); lo[1] = __builtin_bit_cast(float, v.x & 0xffff0000u); lo[2] = __builtin_bit_cast(float, v.y << 16); lo[3] = __builtin_bit_cast(float, v.y & 0xffff0000u);
        hi4[0] = __builtin_bit_cast(float, v.z << 16); hi4[1] = __builtin_bit_cast(float, v.z & 0xffff0000u); hi4[2] = __builtin_bit_cast(float, v.w << 16); hi4[3] = __builtin_bit_cast(float, v.w & 0xffff0000u);
        *(LAS f32x4*)(xs + row * 64 + c8 * 8) = lo; *(LAS f32x4*)(xs + row * 64 + c8 * 8 + 4) = hi4;
    }
    __syncthreads();
    {
        const int c = tid & 63, cg = hb * 64 + c;
        const float w0 = P.cw[cg], w1 = P.cw[1024 + cg], w2 = P.cw[2048 + cg], w3 = P.cw[3072 + cg], bb = P.cb[cg];
#pragma unroll 4
        for (int i = 0; i < 16; ++i) { const int t = (tid >> 6) + 8 * i;
            xc[t * LR_XCS + c] = bb + w0 * xs[t * 64 + c] + w1 * xs[(t + 1) * 64 + c] + w2 * xs[(t + 2) * 64 + c] + w3 * xs[(t + 3) * 64 + c]; }
    }
    __syncthreads();
    {
        const int fr = lane & 15, fq = lane >> 4;
        bf16x8 af[2];
#pragma unroll
        for (int kk = 0; kk < 2; ++kk) { const LAS float* xp = xc + (16 * w + fr) * LR_XCS + kk * 32 + 8 * fq; const f32x4 x0 = *(const LAS f32x4*)xp, x1 = *(const LAS f32x4*)(xp + 4);
            u32x4 pk; pk.x = pk2(x0[0], x0[1]); pk.y = pk2(x0[2], x0[3]); pk.z = pk2(x1[0], x1[1]); pk.w = pk2(x1[2], x1[3]); af[kk] = __builtin_bit_cast(bf16x8, pk); }
#pragma unroll
        for (int nt = 0; nt < 4; ++nt) {
            f32x4 R = (f32x4){0.f, 0.f, 0.f, 0.f}, I = (f32x4){0.f, 0.f, 0.f, 0.f};
#pragma unroll
            for (int kk = 0; kk < 2; ++kk) {
                const size_t wo = ((size_t)(hb * 64 + nt * 16 + fr)) * 64 + kk * 32 + 8 * fq;
                const bf16x8 wa = *(const bf16x8*)(P.WaT + wo), wi = *(const bf16x8*)(P.WiT + wo);
                R = __builtin_amdgcn_mfma_f32_16x16x32_bf16(af[kk], wa, R, 0, 0, 0);
                I = __builtin_amdgcn_mfma_f32_16x16x32_bf16(af[kk], wi, I, 0, 0, 0);
            }
            const int cl = nt * 16 + fr, cg = hb * 64 + cl;
            const float bav = P.ba[cg], biv = P.bi[cg], nl = -P.lam[cg];
            const float sp = fmaxf(nl, 0.f) + log1pf(expf(-fabsf(nl)));
#pragma unroll
            for (int r = 0; r < 4; ++r) {
                const int tl = 16 * w + 4 * fq + r;
                const float rg = fast_sigmoid(R[r] + bav), ig = fast_sigmoid(I[r] + biv);
                const float log_a = -8.0f * rg * sp;
                const float a = expf(log_a), u = sqrtf(-expm1f(2.0f * log_a)) * (ig * xc[tl * LR_XCS + cl]);
                ab[tl * 64 + cl] = a; xc[tl * LR_XCS + cl] = u;
            }
        }
    }
    __syncthreads();
    const int c = lane, seg = w;
    {
        float A = 1.f, H = 0.f;
#pragma unroll 4
        for (int i = 0; i < 16; ++i) { const int t = seg * 16 + i; const float a = ab[t * 64 + c], u = xc[t * LR_XCS + c]; H = a * H + u; A *= a; }
        segA[seg * 64 + c] = A; segH[seg * 64 + c] = H;
    }
    __syncthreads();
    if (PASS == 1) {
        if (tid < 64) { float A = 1.f, H = 0.f;
#pragma unroll
            for (int s2 = 0; s2 < 8; ++s2) { const float a = segA[s2 * 64 + tid], h = segH[s2 * 64 + tid]; H = a * H + h; A *= a; }
            float* ag = P.AGG + (((size_t)b * 16 + ch) * 1024 + hb * 64 + tid) * 2; ag[0] = A; ag[1] = H; }
        __syncthreads();
    } else {
        if (tid < 64) { float h = 0.f;
            for (int k2 = 0; k2 < ch; ++k2) { const float* ag = P.AGG + (((size_t)b * 16 + k2) * 1024 + hb * 64 + tid) * 2; h = ag[0] * h + ag[1]; }
            cin[tid] = h; }
        __syncthreads();
        {
            float h = cin[c];
            for (int s2 = 0; s2 < seg; ++s2) h = segA[s2 * 64 + c] * h + segH[s2 * 64 + c];
#pragma unroll 4
            for (int i = 0; i < 16; ++i) { const int t = seg * 16 + i; h = ab[t * 64 + c] * h + xc[t * LR_XCS + c]; ab[t * 64 + c] = h; }
        }
        __syncthreads();
        for (int i = tid; i < 128 * 8; i += 512) {
            const int row = i >> 3, c8 = i & 7;
            const size_t go = (size_t)(rowb + c0 + row) * 1024 + hb * 64 + c8 * 8;
            const u32x4 v = *(const u32x4*)(P.GG + go);
            const f32x4 h0 = *(const LAS f32x4*)(ab + row * 64 + c8 * 8), h1 = *(const LAS f32x4*)(ab + row * 64 + c8 * 8 + 4);
            u32x4 o;
            o.x = pk2(__builtin_bit_cast(float, v.x << 16) * h0[0], __builtin_bit_cast(float, v.x & 0xffff0000u) * h0[1]);
            o.y = pk2(__builtin_bit_cast(float, v.y << 16) * h0[2], __builtin_bit_cast(float, v.y & 0xffff0000u) * h0[3]);
            o.z = pk2(__builtin_bit_cast(float, v.z << 16) * h1[0], __builtin_bit_cast(float, v.z & 0xffff0000u) * h1[1]);
            o.w = pk2(__builtin_bit_cast(float, v.w << 16) * h1[2], __builtin_bit_cast(float, v.w & 0xffff0000u) * h1[3]);
            *(u32x4*)(P.GAo + go) = o;
        }
        __syncthreads();
    }
}
template <int PASS>
__device__ __forceinline__ void lru_phase(Frame& F, const LruPtrs& P) {
    const int nitems = P.nb * 256;
    for (int it = F.bid; it < nitems; it += F.G) { const int b = it >> 8, ch = (it >> 4) & 15, hb = it & 15; lru_item<PASS>(F, P, b, hb, ch); }
}

constexpr int LS_XS = 0, LS_XC = 33792, LS_A = LS_XC + 128 * LR_XCS * 4, LS_SEG = LS_A + 16384, LS_CARRY = LS_SEG + 4096, LS_END = LS_CARRY + 128;
static_assert(LS_END <= STAGE_BYTES, "lru-seq LDS map");
__device__ __forceinline__ void lru_seq_item(Frame& F, const LruPtrs& P, int b, int hb, int half) {
    LAS unsigned char* lds = F.lds;
    int tid = threadIdx.x; asm volatile("" : "+v"(tid));
    const int lane = tid & 63, w = __builtin_amdgcn_readfirstlane(tid >> 6);
    LAS float* xs = (LAS float*)(lds + LS_XS); LAS float* xc = (LAS float*)(lds + LS_XC); LAS float* ab = (LAS float*)(lds + LS_A);
    LAS float* segA = (LAS float*)(lds + LS_SEG); LAS float* segH = segA + 512; LAS float* carry = (LAS float*)(lds + LS_CARRY);
    const long rowb = (long)b * S;
    const int fr = lane & 15, fq = lane >> 4;
    float bav[2], biv[2], spl[2]; bf16x8 waf[2][2], wif[2][2];
#pragma unroll
    for (int nt = 0; nt < 2; ++nt) { const int cl = half * 32 + nt * 16 + fr, cg = hb * 64 + cl;
        bav[nt] = P.ba[cg]; biv[nt] = P.bi[cg]; const float nl = -P.lam[cg]; spl[nt] = -8.0f * (fmaxf(nl, 0.f) + log1pf(expf(-fabsf(nl))));
#pragma unroll
        for (int kk = 0; kk < 2; ++kk) { const size_t wo = ((size_t)(hb * 64 + cl)) * 64 + kk * 32 + 8 * fq; waf[nt][kk] = *(const bf16x8*)(P.WaT + wo); wif[nt][kk] = *(const bf16x8*)(P.WiT + wo); } }
    const int cc = tid & 63, cgc = hb * 64 + cc;
    const float w0 = P.cw[cgc], w1 = P.cw[1024 + cgc], w2 = P.cw[2048 + cgc], w3 = P.cw[3072 + cgc], bb = P.cb[cgc];
    if (tid < 32) carry[tid] = 0.f;
    u32x4 pre[3];
#pragma unroll
    for (int j = 0; j < 3; ++j) { const int i = tid + 512 * j; pre[j] = (u32x4){0u, 0u, 0u, 0u};
        if (i < 131 * 8) { const int row = i >> 3, c8 = i & 7, t = row - 3; if (t >= 0) pre[j] = *(const u32x4*)(P.XR + (rowb + t) * 1024 + hb * 64 + c8 * 8); } }
    for (int ch = 0; ch < 16; ++ch) {
        const int c0 = ch * 128;
#pragma unroll
        for (int j = 0; j < 3; ++j) { const int i = tid + 512 * j;
            if (i < 131 * 8) { const int row = i >> 3, c8 = i & 7; const u32x4 v = pre[j]; f32x4 lo, hi4;
                lo[0] = __builtin_bit_cast(float, v.x << 16); lo[1] = __builtin_bit_cast(float, v.x & 0xffff0000u); lo[2] = __builtin_bit_cast(float, v.y << 16); lo[3] = __builtin_bit_cast(float, v.y & 0xffff0000u);
                hi4[0] = __builtin_bit_cast(float, v.z << 16); hi4[1] = __builtin_bit_cast(float, v.z & 0xffff0000u); hi4[2] = __builtin_bit_cast(float, v.w << 16); hi4[3] = __builtin_bit_cast(float, v.w & 0xffff0000u);
                *(LAS f32x4*)(xs + row * 64 + c8 * 8) = lo; *(LAS f32x4*)(xs + row * 64 + c8 * 8 + 4) = hi4; } }
        __syncthreads();
        const size_t go = (size_t)(rowb + c0 + (tid >> 2)) * 1024 + hb * 64 + half * 32 + (tid & 3) * 8;
        const u32x4 ggv = *(const u32x4*)(P.GG + go);
        if (ch + 1 < 16) {
#pragma unroll
            for (int j = 0; j < 3; ++j) { const int i = tid + 512 * j;
                if (i < 131 * 8) { const int row = i >> 3, c8 = i & 7; pre[j] = *(const u32x4*)(P.XR + (rowb + c0 + 128 - 3 + row) * 1024 + hb * 64 + c8 * 8); } }
        }
#pragma unroll 4
        for (int i = 0; i < 16; ++i) { const int t = (tid >> 6) + 8 * i;
            xc[t * LR_XCS + cc] = bb + w0 * xs[t * 64 + cc] + w1 * xs[(t + 1) * 64 + cc] + w2 * xs[(t + 2) * 64 + cc] + w3 * xs[(t + 3) * 64 + cc]; }
        __syncthreads();
        {
            bf16x8 af[2];
#pragma unroll
            for (int kk = 0; kk < 2; ++kk) { const LAS float* xp = xc + (16 * w + fr) * LR_XCS + kk * 32 + 8 * fq; const f32x4 x0 = *(const LAS f32x4*)xp, x1 = *(const LAS f32x4*)(xp + 4);
                u32x4 pk; pk.x = pk2(x0[0], x0[1]); pk.y = pk2(x0[2], x0[3]); pk.z = pk2(x1[0], x1[1]); pk.w = pk2(x1[2], x1[3]); af[kk] = __builtin_bit_cast(bf16x8, pk); }
            f32x4 R[2], I[2];
#pragma unroll
            for (int nt = 0; nt < 2; ++nt) { R[nt] = (f32x4){0.f, 0.f, 0.f, 0.f}; I[nt] = (f32x4){0.f, 0.f, 0.f, 0.f};
#pragma unroll
                for (int kk = 0; kk < 2; ++kk) { R[nt] = __builtin_amdgcn_mfma_f32_16x16x32_bf16(af[kk], waf[nt][kk], R[nt], 0, 0, 0); I[nt] = __builtin_amdgcn_mfma_f32_16x16x32_bf16(af[kk], wif[nt][kk], I[nt], 0, 0, 0); } }
            float xv[2][4];
#pragma unroll
            for (int nt = 0; nt < 2; ++nt)
#pragma unroll
                for (int r = 0; r < 4; ++r) xv[nt][r] = xc[(16 * w + 4 * fq + r) * LR_XCS + half * 32 + nt * 16 + fr];
#pragma unroll
            for (int nt = 0; nt < 2; ++nt)
#pragma unroll
                for (int r = 0; r < 4; ++r) {
                    const int tl = 16 * w + 4 * fq + r, c32 = nt * 16 + fr;
                    const float rg = fast_sigmoid(R[nt][r] + bav[nt]), ig = fast_sigmoid(I[nt][r] + biv[nt]);
                    const float la2 = rg * spl[nt];
                    const float a = __builtin_amdgcn_exp2f(la2 * 1.4426950408889634f);
                    const float x2 = 2.0f * la2;
                    const float ser = -x2 * (1.0f + x2 * (0.5f + x2 * (0.16666667f + x2 * (0.041666668f + x2 * 0.0083333338f))));
                    const float om = (x2 > -0.25f) ? ser : (1.0f - a * a);
                    ab[tl * 32 + c32] = a; xc[tl * LR_XCS + c32] = __builtin_amdgcn_sqrtf(om) * (ig * xv[nt][r]);
                }
        }
        __syncthreads();
        const int c = tid & 31, seg = tid >> 5;
        {
            float A = 1.f, H = 0.f;
#pragma unroll
            for (int i = 0; i < 8; ++i) { const int t = seg * 8 + i; const float a = ab[t * 32 + c], u = xc[t * LR_XCS + c]; H = a * H + u; A *= a; }
            segA[seg * 32 + c] = A; segH[seg * 32 + c] = H;
        }
        __syncthreads();
        if (tid < 32) {
            float sa[16], sh[16];
#pragma unroll
            for (int s2 = 0; s2 < 16; ++s2) { sa[s2] = segA[s2 * 32 + tid]; sh[s2] = segH[s2 * 32 + tid]; }
            float h = carry[tid];
#pragma unroll
            for (int s2 = 0; s2 < 16; ++s2) { segH[s2 * 32 + tid] = h; h = sa[s2] * h + sh[s2]; }
            carry[tid] = h;
        }
        __syncthreads();
        {
            float h = segH[seg * 32 + c];
#pragma unroll
            for (int i = 0; i < 8; ++i) { const int t = seg * 8 + i; h = ab[t * 32 + c] * h + xc[t * LR_XCS + c]; ab[t * 32 + c] = h; }
        }
        __syncthreads();
        {
            const int row = tid >> 2, c8 = tid & 3;
            const u32x4 v = ggv;
            const f32x4 h0 = *(const LAS f32x4*)(ab + row * 32 + c8 * 8), h1 = *(const LAS f32x4*)(ab + row * 32 + c8 * 8 + 4);
            u32x4 o;
            o.x = pk2(__builtin_bit_cast(float, v.x << 16) * h0[0], __builtin_bit_cast(float, v.x & 0xffff0000u) * h0[1]);
            o.y = pk2(__builtin_bit_cast(float, v.y << 16) * h0[2], __builtin_bit_cast(float, v.y & 0xffff0000u) * h0[3]);
            o.z = pk2(__builtin_bit_cast(float, v.z << 16) * h1[0], __builtin_bit_cast(float, v.z & 0xffff0000u) * h1[1]);
            o.w = pk2(__builtin_bit_cast(float, v.w << 16) * h1[2], __builtin_bit_cast(float, v.w & 0xffff0000u) * h1[3]);
            *(u32x4*)(P.GAo + go) = o;
        }
    }
    __syncthreads();
}
constexpr int L2_XS = 0, L2_XSB = 131 * 128  , L2_XC = 4 * L2_XSB  , L2_XCS = 144  , L2_A = L2_XC + 128 * L2_XCS, L2_CS = 132  ,
              L2_U = L2_A + 32 * L2_CS * 4, L2_HC = L2_XC  , L2_HS = 129, L2_GG = L2_U + 32 * L2_CS * 4  , L2_END = L2_GG + 4 * 8192;
static_assert(32 * L2_HS * 4 <= 128 * L2_XCS, "lru LDS map");
static_assert(L2_END <= LDS_BYTES - 4096, "lru LDS map");
template <int SH> __device__ __forceinline__ float row_shr(float v, float ident) {
    return __builtin_bit_cast(float, __builtin_amdgcn_update_dpp(__builtin_bit_cast(int, ident), __builtin_bit_cast(int, v), 0x110 | SH, 0xf, 0xf, false)); }
__device__ __forceinline__ void lru2_item(Frame& F, const LruPtrs& P, int b, int hb, int half) {
    LAS unsigned char* lds = F.lds;
    int tid = threadIdx.x; asm volatile("" : "+v"(tid));
    const int lane = tid & 63, w = __builtin_amdgcn_readfirstlane(tid >> 6);
    const long rowb = (long)b * S;
    const int fr = lane & 15, fq = lane >> 4;
    float bav[2], biv[2], spl[2]; bf16x8 waf[2][2], wif[2][2];
#pragma unroll
    for (int nt = 0; nt < 2; ++nt) { const int cl = half * 32 + nt * 16 + fr, cg = hb * 64 + cl;
        bav[nt] = P.ba[cg]; biv[nt] = P.bi[cg]; const float nl = -P.lam[cg]; spl[nt] = -8.0f * 1.4426950408889634f * (fmaxf(nl, 0.f) + log1pf(expf(-fabsf(nl))));
#pragma unroll
        for (int kk = 0; kk < 2; ++kk) { const size_t wo = ((size_t)(hb * 64 + cl)) * 64 + kk * 32 + 8 * fq; waf[nt][kk] = *(const bf16x8*)(P.WaT + wo); wif[nt][kk] = *(const bf16x8*)(P.WiT + wo); } }
    const int cp = tid & 31, tg = tid >> 5, cg0 = hb * 64 + 2 * cp;
    const f32x2 cw0 = {P.cw[cg0], P.cw[cg0 + 1]}, cw1 = {P.cw[1024 + cg0], P.cw[1024 + cg0 + 1]}, cw2 = {P.cw[2048 + cg0], P.cw[2048 + cg0 + 1]}, cw3 = {P.cw[3072 + cg0], P.cw[3072 + cg0 + 1]}, cbb = {P.cb[cg0], P.cb[cg0 + 1]};
    float carry = 0.f;
    const unsigned l0 = (unsigned)(size_t)lds;
#define LRU_DMA(k_) do { const int c0_ = (k_) * 128; const unsigned bo_ = l0 + L2_XS + ((k_) & 3) * L2_XSB; \
        const bf16_t* s_ = P.XR + (rowb + c0_ + (lane >> 3)) * 1024 + hb * 64 + (lane & 7) * 8; \
        glds16(s_ + (long)(8 * w) * 1024, (unsigned)__builtin_amdgcn_readfirstlane(bo_ + (3 + 8 * w) * 128)); \
        glds16(s_ + (long)(8 * w + 64) * 1024, (unsigned)__builtin_amdgcn_readfirstlane(bo_ + (3 + 8 * w + 64) * 128)); \
        if (w == 0 && (k_) > 0) { if (lane < 24) glds16(s_ - 3 * 1024, (unsigned)__builtin_amdgcn_readfirstlane(bo_)); } \
        glds16(P.GG + (rowb + c0_ + 16 * w + (lane >> 2)) * 1024 + hb * 64 + half * 32 + (lane & 3) * 8, (unsigned)__builtin_amdgcn_readfirstlane(l0 + L2_GG + ((k_) & 3) * 8192 + w * 1024)); } while (0)
    if (tid < 96) ((LAS unsigned*)(lds + L2_XS))[tid] = 0u;
    LRU_DMA(0); LRU_DMA(1); LRU_DMA(2);
#define LRU_WAIT(n_) asm volatile("s_waitcnt vmcnt(" #n_ ") lgkmcnt(0)" ::: "memory")
    for (int ch = 0; ch < 16; ++ch) {
        int lt = tid; asm volatile("" : "+v"(lt));
        const int c0 = ch * 128;
        { const int need = (ch >= 14) ? 0 : ((w == 0 ? 8 : 6) + (ch < 3 ? ch : 3));
          if (need == 0) LRU_WAIT(0); else if (need == 6) LRU_WAIT(6); else if (need == 7) LRU_WAIT(7); else if (need == 8) LRU_WAIT(8); else if (need == 9) LRU_WAIT(9); else if (need == 10) LRU_WAIT(10); else LRU_WAIT(11); }
        __builtin_amdgcn_s_barrier(); asm volatile("" ::: "memory");
        if (ch + 3 < 16) LRU_DMA(ch + 3);
        const size_t go = (size_t)(rowb + c0 + (lt >> 2)) * 1024 + hb * 64 + half * 32 + (lt & 3) * 8;
        {
            const LAS unsigned* xs = (const LAS unsigned*)(lds + L2_XS + (ch & 3) * L2_XSB) + (8 * (lt >> 5)) * 32 + (lt & 31);
            LAS unsigned* xo = (LAS unsigned*)(lds + L2_XC) + (8 * (lt >> 5)) * (L2_XCS / 4) + (lt & 31);
            f32x2 x0, x1, x2;
            { const unsigned a0 = xs[0], a1 = xs[32], a2 = xs[64];
              x0 = (f32x2){__builtin_bit_cast(float, a0 << 16), __builtin_bit_cast(float, a0 & 0xffff0000u)}; x1 = (f32x2){__builtin_bit_cast(float, a1 << 16), __builtin_bit_cast(float, a1 & 0xffff0000u)};
              x2 = (f32x2){__builtin_bit_cast(float, a2 << 16), __builtin_bit_cast(float, a2 & 0xffff0000u)}; }
#pragma unroll
            for (int t = 0; t < 8; ++t) { const unsigned a3 = xs[(t + 3) * 32]; const f32x2 x3 = (f32x2){__builtin_bit_cast(float, a3 << 16), __builtin_bit_cast(float, a3 & 0xffff0000u)};
                const f32x2 o = cbb + cw0 * x0 + cw1 * x1 + cw2 * x2 + cw3 * x3;
                xo[t * (L2_XCS / 4)] = pk2(o.x, o.y); x0 = x1; x1 = x2; x2 = x3; }
        }
        asm volatile("s_waitcnt lgkmcnt(0)" ::: "memory"); __builtin_amdgcn_s_barrier(); asm volatile("" ::: "memory");
        {
            const int lw = __builtin_amdgcn_readfirstlane(lt >> 6), lfr = lt & 15, lfq = (lt & 63) >> 4;
            bf16x8 af[2];
#pragma unroll
            for (int kk = 0; kk < 2; ++kk) af[kk] = *(const LAS bf16x8*)(lds + L2_XC + (16 * lw + lfr) * L2_XCS + kk * 64 + lfq * 16);
            f32x4 R[2], I[2];
#pragma unroll
            for (int nt = 0; nt < 2; ++nt) { R[nt] = (f32x4){0.f, 0.f, 0.f, 0.f}; I[nt] = (f32x4){0.f, 0.f, 0.f, 0.f};
#pragma unroll
                for (int kk = 0; kk < 2; ++kk) { R[nt] = __builtin_amdgcn_mfma_f32_16x16x32_bf16(af[kk], waf[nt][kk], R[nt], 0, 0, 0); I[nt] = __builtin_amdgcn_mfma_f32_16x16x32_bf16(af[kk], wif[nt][kk], I[nt], 0, 0, 0); } }
            const LAS unsigned short* xh = (const LAS unsigned short*)(lds + L2_XC);
#pragma unroll
            for (int nt = 0; nt < 2; ++nt) {
                f32x4 av, uv;
#pragma unroll
                for (int r = 0; r < 4; ++r) {
                    const float xv = bf2f(xh[(16 * lw + 4 * lfq + r) * (L2_XCS / 2) + half * 32 + nt * 16 + lfr]);
                    const float rg = fast_sigmoid(R[nt][r] + bav[nt]), ig = fast_sigmoid(I[nt][r] + biv[nt]);
                    const float a = __builtin_amdgcn_exp2f(rg * spl[nt]);
                    const float om = __builtin_fmaf(-a, a, 1.0f);
                    av[r] = a; uv[r] = __builtin_amdgcn_sqrtf(om) * (ig * xv);
                }
                *(LAS f32x4*)(lds + L2_A + ((nt * 16 + lfr) * L2_CS + 16 * lw + 4 * lfq) * 4) = av;
                *(LAS f32x4*)(lds + L2_U + ((nt * 16 + lfr) * L2_CS + 16 * lw + 4 * lfq) * 4) = uv;
            }
        }
        asm volatile("s_waitcnt lgkmcnt(0)" ::: "memory"); __builtin_amdgcn_s_barrier(); asm volatile("" ::: "memory");
        {
            const int lw = __builtin_amdgcn_readfirstlane(lt >> 6), sc = 4 * lw + ((lt & 63) >> 4), seg = lt & 15;
            const LAS float* ap = (const LAS float*)(lds + L2_A) + sc * L2_CS + seg * 8; const LAS float* up = (const LAS float*)(lds + L2_U) + sc * L2_CS + seg * 8;
            const f32x4 a0 = *(const LAS f32x4*)ap, a1 = *(const LAS f32x4*)(ap + 4), u0 = *(const LAS f32x4*)up, u1 = *(const LAS f32x4*)(up + 4);
            float A = a0[0], H = u0[0];
#pragma unroll
            for (int i = 1; i < 4; ++i) { H = a0[i] * H + u0[i]; A *= a0[i]; }
#pragma unroll
            for (int i = 0; i < 4; ++i) { H = a1[i] * H + u1[i]; A *= a1[i]; }
            { const float Ap = row_shr<1>(A, 1.f), Hp = row_shr<1>(H, 0.f); H = A * Hp + H; A = A * Ap; }
            { const float Ap = row_shr<2>(A, 1.f), Hp = row_shr<2>(H, 0.f); H = A * Hp + H; A = A * Ap; }
            { const float Ap = row_shr<4>(A, 1.f), Hp = row_shr<4>(H, 0.f); H = A * Hp + H; A = A * Ap; }
            { const float Ap = row_shr<8>(A, 1.f), Hp = row_shr<8>(H, 0.f); H = A * Hp + H; A = A * Ap; }
            const float Ae = row_shr<1>(A, 1.f), He = row_shr<1>(H, 0.f);
            float h = Ae * carry + He;
            const float tot = A * carry + H;
            carry = __builtin_bit_cast(float, __builtin_amdgcn_ds_bpermute(((lt & 63) | 15) << 2, __builtin_bit_cast(int, tot)));
            LAS float* hp = (LAS float*)(lds + L2_HC) + sc * L2_HS + seg * 8;
#pragma unroll
            for (int i = 0; i < 4; ++i) { h = a0[i] * h + u0[i]; hp[i] = h; }
#pragma unroll
            for (int i = 0; i < 4; ++i) { h = a1[i] * h + u1[i]; hp[4 + i] = h; }
        }
        asm volatile("s_waitcnt lgkmcnt(0)" ::: "memory"); __builtin_amdgcn_s_barrier(); asm volatile("" ::: "memory");
        {
            const LAS float* hp = (const LAS float*)(lds + L2_HC) + ((lt & 3) * 8) * L2_HS + (lt >> 2);
            const u32x4 v = *(const LAS u32x4*)(lds + L2_GG + (ch & 3) * 8192 + lt * 16);
            u32x4 o;
            o.x = pk2(__builtin_bit_cast(float, v.x << 16) * hp[0 * L2_HS], __builtin_bit_cast(float, v.x & 0xffff0000u) * hp[1 * L2_HS]);
            o.y = pk2(__builtin_bit_cast(float, v.y << 16) * hp[2 * L2_HS], __builtin_bit_cast(float, v.y & 0xffff0000u) * hp[3 * L2_HS]);
            o.z = pk2(__builtin_bit_cast(float, v.z << 16) * hp[4 * L2_HS], __builtin_bit_cast(float, v.z & 0xffff0000u) * hp[5 * L2_HS]);
            o.w = pk2(__builtin_bit_cast(float, v.w << 16) * hp[6 * L2_HS], __builtin_bit_cast(float, v.w & 0xffff0000u) * hp[7 * L2_HS]);
            if (P.ready) store16_wt(P.GAo + go, o); else *(u32x4*)(P.GAo + go) = o;
        }
    }
#undef LRU_WAIT
#undef LRU_DMA
    asm volatile("s_waitcnt vmcnt(0)" ::: "memory");
    __syncthreads();
    if (P.ready && tid == 0) __hip_atomic_fetch_add(P.ready + 4 * b, 1u, __ATOMIC_RELAXED, __HIP_MEMORY_SCOPE_AGENT);
}
__device__ __forceinline__ void lru_seq_phase(Frame& F, const LruPtrs& P) {
    for (int wi = F.bid; wi < P.nb * 32; wi += F.G) lru2_item(F, P, wi >> 5, (wi >> 1) & 15, wi & 1);
}

struct CmpPtrs { const bf16_t *KC, *VC; const bf16_t *W1Tk, *W1Tv, *W2Tk, *W2Tv; const float *b1k, *b1v, *b1part, *b2k, *b2v; const float* CS; bf16_t *KCMP, *VCMP; int nb; unsigned* ready; };
constexpr int CM_TILE = 0, CM_H = 528 * 128, CM_HS = 528  , CM_END = CM_H + 32 * CM_HS;
static_assert(CM_END <= STAGE_BYTES, "compress LDS map");
__device__ __forceinline__ float gelu_tanh_f(float x) { const float p = __builtin_fmaf(x * x, -0.10294324f, -2.3022082f); return x * __builtin_amdgcn_rcpf(1.0f + __builtin_amdgcn_exp2f(x * p)); }
__device__ __forceinline__ void cmp_item(Frame& F, const CmpPtrs& P, int b, int g, int kv, int mq) {
    LAS unsigned char* lds = F.lds;
    int tid = threadIdx.x; asm volatile("" : "+v"(tid));
    const int lane = tid & 63, w = __builtin_amdgcn_readfirstlane(tid >> 6), nl = lane & 31, hi = lane >> 5;
    const bf16_t* src = kv ? P.VC : P.KC; const bf16_t* W1T = kv ? P.W1Tv : P.W1Tk; const bf16_t* W2T = kv ? P.W2Tv : P.W2Tk;
    const int n0 = 32 * mq; const long rowb = (long)b * S;
    const bf16_t* wrow = W1T + ((size_t)w * 128 * 64 + lane) * 8;
    bf16x8 bA[8], bB[8];
    {
        u32x4 tv[9];
#pragma unroll
        for (int u = 0; u < 9; ++u) { const int i = tid + 512 * u, row = i >> 3, ci = i & 7, tok = 16 * n0 + row;
            tv[u] = (u32x4){0u, 0u, 0u, 0u};
            if (i < 528 * 8 && tok < S) tv[u] = *(const u32x4*)(src + (rowb + tok) * 256 + g * 64 + ci * 8); }
#pragma unroll
        for (int i = 0; i < 8; ++i) bA[i] = *(const bf16x8*)(wrow + 512 * i);
#pragma unroll
        for (int u = 0; u < 9; ++u) { const int i = tid + 512 * u, row = i >> 3, ci = i & 7;
            if (i < 528 * 8) *(LAS u32x4*)(lds + CM_TILE + row * 128 + ((ci ^ ((row >> 4) & 7)) * 16)) = tv[u]; }
    }
    __syncthreads();
    f32x16 acc;
#pragma unroll
    for (int r = 0; r < 16; ++r) acc[r] = 0.f;
#define CM_STEP(BW, ks_) do { const int ks = (ks_), j = ks >> 2, row = 16 * nl + j, ci = 2 * (ks & 3) + hi; \
        const bf16x8 a = *(const LAS bf16x8*)(lds + CM_TILE + row * 128 + ((ci ^ ((row >> 4) & 7)) * 16)); acc = __builtin_amdgcn_mfma_f32_32x32x16_bf16(a, BW, acc, 0, 0, 0); } while (0)
#pragma unroll 1
    for (int kb = 0; kb < 128; kb += 16) {
#pragma unroll
        for (int i = 0; i < 8; ++i) bB[i] = *(const bf16x8*)(wrow + 512 * (kb + 8 + i));
#pragma unroll
        for (int i = 0; i < 8; ++i) CM_STEP(bA[i], kb + i);
        if (kb + 16 < 128) {
#pragma unroll
            for (int i = 0; i < 8; ++i) bA[i] = *(const bf16x8*)(wrow + 512 * (kb + 16 + i));
        }
#pragma unroll
        for (int i = 0; i < 8; ++i) CM_STEP(bB[i], kb + 8 + i);
    }
#undef CM_STEP
    {
        const int c = 32 * w + nl;
        float bias = (kv ? P.b1v : P.b1k)[c];
#pragma unroll
        for (int sl = 0; sl < 16; ++sl) bias += P.b1part[(kv * 16 + sl) * 256 + c];
#pragma unroll
        for (int r = 0; r < 16; ++r) { const int n = (r & 3) + 8 * (r >> 2) + 4 * hi;
            *(LAS bf16_t*)(lds + CM_H + n * CM_HS + c * 2) = (bf16_t)f2bf(gelu_tanh_f(acc[r] + bias)); }
    }
    __syncthreads();
    {
        f32x16 a0, a1;
#pragma unroll
        for (int r = 0; r < 16; ++r) { a0[r] = 0.f; a1[r] = 0.f; }
#pragma unroll
        for (int kk = 0; kk < 2; ++kk) { const int ks = 2 * w + kk;
            const bf16x8 a = *(const LAS bf16x8*)(lds + CM_H + nl * CM_HS + (16 * ks + 8 * hi) * 2);
            const bf16x8 b0 = *(const bf16x8*)(W2T + (size_t)nl * 256 + 16 * ks + 8 * hi), b1 = *(const bf16x8*)(W2T + (size_t)(nl + 32) * 256 + 16 * ks + 8 * hi);
            a0 = __builtin_amdgcn_mfma_f32_32x32x16_bf16(a, b0, a0, 0, 0, 0);
            a1 = __builtin_amdgcn_mfma_f32_32x32x16_bf16(a, b1, a1, 0, 0, 0);
        }
        LAS float* red = (LAS float*)(lds + CM_TILE);
#pragma unroll
        for (int r = 0; r < 16; ++r) { red[(w * 32 + r) * 64 + lane] = a0[r]; red[(w * 32 + 16 + r) * 64 + lane] = a1[r]; }
    }
    __syncthreads();
    {
        const LAS float* red = (const LAS float*)(lds + CM_TILE);
        const float* b2 = kv ? P.b2v : P.b2k; const int ln = tid & 63, nl2 = ln & 31, hi2 = ln >> 5; const float bb0 = b2[nl2], bb1 = b2[nl2 + 32];
#pragma unroll
        for (int jj = 0; jj < 2; ++jj) {
            const int r = (tid >> 6) + 8 * jj;
            float x1 = 0.f, x2 = 0.f;
#pragma unroll
            for (int ww = 0; ww < 8; ++ww) { x1 += red[(ww * 32 + r) * 64 + ln]; x2 += red[(ww * 32 + 16 + r) * 64 + ln]; }
            x1 += bb0; x2 += bb1;
            const int n = n0 + (r & 3) + 8 * (r >> 2) + 4 * hi2;
            if (n >= 127) { x1 = 0.f; x2 = 0.f; }
            if (kv == 0) {
                const int pos = n < 127 ? 16 * n + 31 : 0; const f32x2 cs = *(const f32x2*)(P.CS + ((size_t)pos * 32 + nl2) * 2);
                const float y1 = x1 * cs.x - x2 * cs.y, y2 = x2 * cs.x + x1 * cs.y;
                __hip_atomic_store((unsigned*)(P.KCMP + ((size_t)(b * 128 + n) * 256 + g * 64 + 2 * nl2)), pk2(y1, y2), __ATOMIC_RELAXED, __HIP_MEMORY_SCOPE_AGENT);
            } else {
                bf16_t* vp = P.VCMP + ((size_t)(b * 128 + n) * 256 + g * 64);
                __hip_atomic_store(vp + nl2, (bf16_t)f2bf(x1), __ATOMIC_RELAXED, __HIP_MEMORY_SCOPE_AGENT); __hip_atomic_store(vp + nl2 + 32, (bf16_t)f2bf(x2), __ATOMIC_RELAXED, __HIP_MEMORY_SCOPE_AGENT);
            }
        }
    }
    if (P.ready) { asm volatile("s_waitcnt vmcnt(0)" ::: "memory"); __syncthreads(); if (tid == 0) __hip_atomic_fetch_add(P.ready + 8 * (b * 4 + g), 1u, __ATOMIC_RELAXED, __HIP_MEMORY_SCOPE_AGENT); }
    __syncthreads();
}
__device__ __forceinline__ void cmp_phase(Frame& F, const CmpPtrs& P) {
    const int nitems = P.nb * 32;
    for (int it = F.bid; it < nitems; it += F.G) { const int b = it >> 5, g = (it >> 3) & 3, kv = (it >> 2) & 1, mq = it & 3; cmp_item(F, P, b, g, kv, mq); }
}

constexpr float QSCALE = 0.125f * 1.4426950408889634f;
constexpr int NPROJ = 6912;
__device__ __forceinline__ int win_src_col(int j) {
    if (j < 2048) return j;
    if (j < 3072) { const int c = j - 2048, hh = c >> 6, p = c & 63; return 2048 + hh * 64 + (p >> 1) + 32 * (p & 1); }
    if (j < 4608) { const int c = j - 3072, sec = c >> 8, cc = c & 255, g = cc >> 6, p = cc & 63; const int d = (sec == 2 || sec == 4) ? ((p >> 1) + 32 * (p & 1)) : p; return 3072 + sec * 256 + g * 64 + d; }
    if (j < 6656) return 4656 + (j - 4608);
    if (j < 6704) return 4608 + (j - 6656);
    return -1;
}
struct SrcWin { const float* w;
    __device__ __forceinline__ const float* ptr(int k, int n0, int q) const {
        int base;
        if (n0 < 4608) base = n0; else if (n0 < 6656) base = n0 + 48; else if (n0 == 6656 && q < 12) base = 4608; else return nullptr;
        return w + (size_t)k * 6704 + base + 4 * q; }
    __device__ __forceinline__ int dst(int n0, int q, int e) const {
        const int sec = (n0 - 3072) >> 8; const bool perm = (n0 >= 2048 && n0 < 3072) || (n0 >= 3072 && n0 < 4608 && (sec == 2 || sec == 4));
        const int d = 4 * q + e; return perm ? 2 * (d & 31) + (d >> 5) : d; } };
__device__ __forceinline__ void store8(bf16_t* dst, const f32x4& v0, const f32x4& v1) {
    u32x4 o; o.x = pk2(v0[0], v0[1]); o.y = pk2(v0[2], v0[3]); o.z = pk2(v1[0], v1[1]); o.w = pk2(v1[2], v1[3]); *(u32x4*)dst = o;
}
struct EpiProj {
    static constexpr bool PERM = true; static constexpr bool CARRY = false;
    unsigned char* ws; const float* CS;
    __device__ __forceinline__ void operator()(const f32x4 (&acc)[2][2][4][2], const Unit& u, int wr, int wc, int fr, int fq) const {
        const int pn = u.pn; const int row0 = u.pm * BM + wr * 64 + fr, cl0 = wc * 32 + 8 * fq;
#pragma unroll
        for (int ai = 0; ai < 2; ++ai)
#pragma unroll
            for (int m = 0; m < 4; ++m) { const size_t r = (size_t)(row0 + ai * HALF + m * 16);
#pragma unroll
                for (int bj = 0; bj < 2; ++bj) {
                    const int cl = cl0 + bj * HALF; f32x4 v0 = acc[ai][bj][m][0], v1 = acc[ai][bj][m][1];
                    if (pn < 4) { store8((bf16_t*)(ws + WS_XR) + r * 1024 + pn * 256 + cl, v0, v1); }
                    else if (pn < 8) {
#pragma unroll
                        for (int j = 0; j < 4; ++j) { v0[j] = gelu_tanh_f(v0[j]); v1[j] = gelu_tanh_f(v1[j]); }
                        store8((bf16_t*)(ws + WS_GG) + r * 1024 + (pn - 4) * 256 + cl, v0, v1); }
                    else if (pn < 12 || pn == 14 || pn == 16) {
                        const int pos = (int)(r & 2047), i0 = (cl & 63) >> 1;
                        const f32x4 c01 = *(const f32x4*)(CS + ((size_t)pos * 32 + i0) * 2), c23 = *(const f32x4*)(CS + ((size_t)pos * 32 + i0) * 2 + 4);
                        const float sc = pn < 12 ? QSCALE : 1.0f;
                        f32x4 y0, y1;
                        y0[0] = (v0[0] * c01[0] - v0[1] * c01[1]) * sc; y0[1] = (v0[1] * c01[0] + v0[0] * c01[1]) * sc;
                        y0[2] = (v0[2] * c01[2] - v0[3] * c01[3]) * sc; y0[3] = (v0[3] * c01[2] + v0[2] * c01[3]) * sc;
                        y1[0] = (v1[0] * c23[0] - v1[1] * c23[1]) * sc; y1[1] = (v1[1] * c23[0] + v1[0] * c23[1]) * sc;
                        y1[2] = (v1[2] * c23[2] - v1[3] * c23[3]) * sc; y1[3] = (v1[3] * c23[2] + v1[2] * c23[3]) * sc;
                        bf16_t* dst = pn < 12 ? (bf16_t*)(ws + WS_Q) + r * 1024 + (pn - 8) * 256 + cl : (bf16_t*)(ws + WS_KV + (size_t)(pn - 12) * 8 * MiB) + r * 256 + cl;
                        store8(dst, y0, y1); }
                    else if (pn < 18) { store8((bf16_t*)(ws + WS_KV + (size_t)(pn - 12) * 8 * MiB) + r * 256 + cl, v0, v1); }
                    else if (pn < 26) {
#pragma unroll
                        for (int j = 0; j < 4; ++j) { v0[j] = fast_sigmoid(v0[j]); v1[j] = fast_sigmoid(v1[j]); }
                        store8((bf16_t*)(ws + WS_MG) + r * 2048 + (pn - 18) * 256 + cl, v0, v1); }
                    else if (cl < 48) {
#pragma unroll
                        for (int j = 0; j < 4; ++j) { v0[j] = fast_sigmoid(v0[j]); v1[j] = fast_sigmoid(v1[j]); }
                        float* dst = (float*)(ws + WS_NG) + r * 48 + cl; *(f32x4*)dst = v0; *(f32x4*)(dst + 4) = v1; }
                }
                asm volatile("" ::: "memory"); }
    }
};
__device__ __forceinline__ void proj_phase(Frame& F, const bf16_t* hN) {
    StaticOrder Sc; Sc.init(T, NPROJ, F.G, F.bid);
    EpiProj E{F.ws, (const float*)(F.ws + WS_CS)};
    DenseA AO{2048u};
    gemm_phase<EpiProj, StaticOrder, DenseA, true>(F.lds, hN, (const bf16_t*)(F.ws + WS_WINT), 1024, Sc, E, AO);
}

struct PairOrder {
    int nM, nN, nwg, G, c;
    __device__ __forceinline__ void init(int M, int N, int G_, int c_) { nM = M / BM; nN = N / BM; nwg = nM * nN; G = G_; c = c_; }
    __device__ __forceinline__ bool next(int i, Unit& u) const {
        const long L = (long)(i >> 1) * G + c; if (L >= nwg) return false;
        int wgid = (int)L; { const int q = nwg / 8, r = nwg % 8, xcd = wgid % 8, off = wgid / 8; wgid = (xcd < r ? xcd * (q + 1) : r * (q + 1) + (xcd - r) * q) + off; }
        const int nig = 8 * nN, gid = wgid / nig, fm = gid * 8, gsz = (nM - fm) < 8 ? (nM - fm) : 8;
        const int sec = i & 1;
        u.pm = fm + ((wgid % nig) % gsz) + sec * nM; u.pn = (wgid % nig) / gsz + sec * nN; u.e = sec; u.r0 = 0; return true;
    }
    unsigned* lrdy = nullptr; unsigned* ordy = nullptr;
    __device__ __forceinline__ void a_ready(const Unit& u) const {
        if (ordy == nullptr) return;
        if (threadIdx.x < 64) {
            const int pmp = u.pm - u.e * nM; const unsigned* p = u.e ? ordy + 4 * pmp : lrdy + 4 * (pmp >> 3); const unsigned need = u.e ? 16u : 32u;
            unsigned sp = 0;
            while ((unsigned)__builtin_amdgcn_readfirstlane(__hip_atomic_load(p, __ATOMIC_RELAXED, __HIP_MEMORY_SCOPE_AGENT)) < need) { __builtin_amdgcn_s_sleep(2); if (++sp > (1u << 22)) break; }
            __builtin_amdgcn_fence(__ATOMIC_ACQUIRE, "agent");
            asm volatile("s_waitcnt vmcnt(0)" ::: "memory");
        }
        asm volatile("" ::: "memory"); __builtin_amdgcn_s_barrier(); asm volatile("" ::: "memory");
    }
};
struct EpiYab {
    static constexpr bool PERM = true; static constexpr bool CARRY = true;
    const bf16_t* MG; bf16_t* Mo; int nM, nN;
    static __device__ __forceinline__ float gfloor(float g) { return fmaxf(g, 8.673617379884035e-19f); }
    __device__ __forceinline__ void carry(f32x4 (&acc)[2][2][4][2], const Unit& u, int wr, int wc, int fr, int fq) const {
        const int row0 = u.pm * BM + wr * 64 + fr; const int col0 = u.pn * BM + wc * 32 + 8 * fq;
#pragma unroll
        for (int ai = 0; ai < 2; ++ai)
#pragma unroll
            for (int m = 0; m < 4; ++m) { const size_t r = (size_t)(row0 + ai * HALF + m * 16);
#pragma unroll
                for (int bj = 0; bj < 2; ++bj) {
                    const int c = col0 + bj * HALF;
                    const u32x4 ga = *(const u32x4*)(MG + r * 2048 + c), gb = *(const u32x4*)(MG + r * 2048 + 1024 + c);
#define YAB_R(A, B, HI) ((HI) ? __builtin_bit_cast(float, (A) & 0xffff0000u) * __builtin_amdgcn_rcpf(gfloor(__builtin_bit_cast(float, (B) & 0xffff0000u))) : __builtin_bit_cast(float, (A) << 16) * __builtin_amdgcn_rcpf(gfloor(__builtin_bit_cast(float, (B) << 16))))
                    acc[ai][bj][m][0][0] *= YAB_R(ga.x, gb.x, 0); acc[ai][bj][m][0][1] *= YAB_R(ga.x, gb.x, 1); acc[ai][bj][m][0][2] *= YAB_R(ga.y, gb.y, 0); acc[ai][bj][m][0][3] *= YAB_R(ga.y, gb.y, 1);
                    acc[ai][bj][m][1][0] *= YAB_R(ga.z, gb.z, 0); acc[ai][bj][m][1][1] *= YAB_R(ga.z, gb.z, 1); acc[ai][bj][m][1][2] *= YAB_R(ga.w, gb.w, 0); acc[ai][bj][m][1][3] *= YAB_R(ga.w, gb.w, 1);
#undef YAB_R
                }
                if (m == 3) asm volatile("" ::: "memory"); }
    }
    __device__ __forceinline__ void operator()(const f32x4 (&acc)[2][2][4][2], const Unit& u, int wr, int wc, int fr, int fq) const {
        const int row0 = (u.pm - nM) * BM + wr * 64 + fr; const int col0 = (u.pn - nN) * BM + wc * 32 + 8 * fq;
#pragma unroll
        for (int ai = 0; ai < 2; ++ai)
#pragma unroll
            for (int m = 0; m < 4; ++m) { const size_t r = (size_t)(row0 + ai * HALF + m * 16);
#pragma unroll
                for (int bj = 0; bj < 2; ++bj) {
                    const int c = col0 + bj * HALF;
                    const u32x4 gv = *(const u32x4*)(MG + r * 2048 + 1024 + c);
                    f32x4 v0 = acc[ai][bj][m][0], v1 = acc[ai][bj][m][1];
                    v0[0] *= gfloor(__builtin_bit_cast(float, gv.x << 16)); v0[1] *= gfloor(__builtin_bit_cast(float, gv.x & 0xffff0000u));
                    v0[2] *= gfloor(__builtin_bit_cast(float, gv.y << 16)); v0[3] *= gfloor(__builtin_bit_cast(float, gv.y & 0xffff0000u));
                    v1[0] *= gfloor(__builtin_bit_cast(float, gv.z << 16)); v1[1] *= gfloor(__builtin_bit_cast(float, gv.z & 0xffff0000u));
                    v1[2] *= gfloor(__builtin_bit_cast(float, gv.w << 16)); v1[3] *= gfloor(__builtin_bit_cast(float, gv.w & 0xffff0000u));
                    u32x4 o; o.x = pk2(v0[0], v0[1]); o.y = pk2(v0[2], v0[3]); o.z = pk2(v1[0], v1[1]); o.w = pk2(v1[2], v1[3]);
                    *(u32x4*)(Mo + r * 1024 + c) = o;
                }
                if (m == 3) asm volatile("" ::: "memory"); }
    }
};
__device__ __forceinline__ void yab_phase(Frame& F, const bf16_t* A2, const bf16_t* WrnT, const bf16_t* MG, bf16_t* Mo, int Mr, unsigned* ordy, unsigned* lrdy) {
    PairOrder Sc; Sc.init(Mr, 1024, F.G, F.bid); Sc.ordy = ordy; Sc.lrdy = lrdy;
    EpiYab E{MG, Mo, Mr / BM, 4};
    DenseA AO{2048u};
    gemm_phase<EpiYab, PairOrder, DenseA, true>(F.lds, A2, WrnT, 1024, Sc, E, AO);
}
struct EpiMix {
    static constexpr bool PERM = true; static constexpr bool CARRY = false;
    const float* x; bf16_t* x1; unsigned* ready;
    __device__ __forceinline__ void operator()(const f32x4 (&acc)[2][2][4][2], const Unit& u, int wr, int wc, int fr, int fq) const {
        const int row0 = u.pm * BM + wr * 64 + fr, col0 = u.pn * BM + wc * 32 + 8 * fq;
#pragma unroll
        for (int ai = 0; ai < 2; ++ai)
#pragma unroll
            for (int m = 0; m < 4; ++m) { const size_t off = (size_t)(row0 + ai * HALF + m * 16) * D + col0;
#pragma unroll
                for (int bj = 0; bj < 2; ++bj) { const f32x4 xa = __builtin_nontemporal_load((const f32x4*)(x + off + bj * HALF)), xb = __builtin_nontemporal_load((const f32x4*)(x + off + bj * HALF + 4));
                    const f32x4 v0 = xa + acc[ai][bj][m][0], v1 = xb + acc[ai][bj][m][1];
                    u32x4 o; o.x = pk2(v0[0], v0[1]); o.y = pk2(v0[2], v0[3]); o.z = pk2(v1[0], v1[1]); o.w = pk2(v1[2], v1[3]);
                    if (ready) store16_wt(x1 + off + bj * HALF, o); else *(u32x4*)(x1 + off + bj * HALF) = o; } }
        if (ready) {
            asm volatile("s_waitcnt vmcnt(0)" ::: "memory");
            if ((threadIdx.x & 63) == 0) __hip_atomic_fetch_add(ready + 16 * u.pm, 1u, __ATOMIC_RELAXED, __HIP_MEMORY_SCOPE_AGENT);
        }
    }
};
__device__ __forceinline__ void mixout_phase(Frame& F, const bf16_t* Mi, const bf16_t* WmT, const float* x, bf16_t* x1, int Mr, unsigned* ready) {
    StaticOrder Sc; Sc.init(Mr, 1024, F.G, F.bid);
    EpiMix E{x, x1, ready};
    DenseA AO{2048u};
    gemm_phase<EpiMix, StaticOrder, DenseA, true>(F.lds, Mi, WmT, 1024, Sc, E, AO);
}
__device__ __forceinline__ void pro_phase(Frame& F, bf16_t* hN) {
    LAS float* scr = (LAS float*)(F.lds + F.wave * CONV_SCR);
    const int gw = F.bid * 8 + F.wave, NGW = F.G * 8;
    constexpr int I_SQ = (1024 / 64) * (1024 / 64);
    bf16_t* WrnT = (bf16_t*)(F.ws + WS_WRNT); bf16_t* WmT = (bf16_t*)(F.ws + WS_WMT);
    if (F.bid == 0 && F.tid < 16) ((unsigned*)(F.ws + WS_GCNT))[F.tid] = 0u;
    {
        SrcWin sw{INP(2)}; bf16_t* WinT = (bf16_t*)(F.ws + WS_WINT);
#define MK_WIN(it, s, K, WT, nblk, r) do { s = sw; K = 1024; WT = WinT; nblk = NPROJ / 64; r = (it); } while (0)
        CONV_LOOP(SrcWin, gw, NGW, 16 * (NPROJ / 64), MK_WIN);
#undef MK_WIN
    }
    if (hN) {
        const float* x = INP(0); const float* g1 = INP(1);
        for (int t = gw; t < T; t += NGW) {
            const f32x4* xr = (const f32x4*)(x + (size_t)t * D) + F.lane; f32x4 v[4]; float ss = 0.f;
#pragma unroll
            for (int j = 0; j < 4; ++j) { v[j] = __builtin_nontemporal_load(&xr[64 * j]); ss += (v[j].x * v[j].x + v[j].y * v[j].y) + (v[j].z * v[j].z + v[j].w * v[j].w); }
            const float rinv = rsqrtf(wave_sum(ss) * (1.f / D) + 1e-6f);
            unsigned long long* o8 = (unsigned long long*)(hN + (size_t)t * D) + F.lane;
#pragma unroll
            for (int j = 0; j < 4; ++j) { const f32x4 gv = ((const f32x4*)g1)[F.lane + 64 * j]; const f32x4 h = v[j] * rinv * gv;
                o8[64 * j] = (unsigned long long)pk2(h.x, h.y) | ((unsigned long long)pk2(h.z, h.w) << 32); }
        }
    }
    const bool spread = (F.G == 256);
    for (int it = spread ? (gw + NGW - 960) % NGW : gw; it < 3 * I_SQ; it += NGW) {
        const int which = it / I_SQ, r = it % I_SQ;
        if (which == 0) { SrcPlain s{INP(10), 1024}; transpose_tile(s, 1024, WrnT, 16, scr, r, F.lane); }
        else if (which == 1) { SrcPlain s{INP(21), 1024}; transpose_tile(s, 1024, WrnT + (size_t)1024 * 1024, 16, scr, r, F.lane); }
        else { SrcPlain s{INP(22), 1024}; transpose_tile(s, 1024, WmT, 16, scr, r, F.lane); }
    }
    {
        bf16_t* W1Tk = (bf16_t*)(F.ws + WS_W1TK); bf16_t* W1Tv = (bf16_t*)(F.ws + WS_W1TV); bf16_t* W2Tk = (bf16_t*)(F.ws + WS_W2T); bf16_t* W2Tv = W2Tk + 64 * 256;
        constexpr int I1 = (2048 / 64) * (256 / 64), I2 = (256 / 64) * (64 / 64);
        for (int it = spread ? (gw + NGW - 696) % NGW : gw; it < 2 * (I1 + I2); it += NGW) { const int kv = it / (I1 + I2), r = it % (I1 + I2);
            if (r < I1) { SrcPlain s{kv ? INP(17) : INP(12), 256}; f32x4 v[16]; tile_load(s, 4, r, F.lane, v); tile_store_w1(s, kv ? W1Tv : W1Tk, 4, scr, r, F.lane, v); }
            else { SrcPlain s{kv ? INP(19) : INP(14), 64}; transpose_tile(s, 256, kv ? W2Tv : W2Tk, 1, scr, r - I1, F.lane); } }
    }
    {
        bf16_t* WRS = (bf16_t*)(F.ws + WS_WRS); const float* rgw = INP(24); const float* rew = INP(26);
        for (int e = F.bid * 512 + F.tid; e < 32 * 1024; e += F.G * 512) { const int n = e >> 10, kk = e & 1023;
            const float v = (n < 4) ? rgw[kk * 4 + n] : (n < 20) ? rew[((size_t)((n - 4) >> 2) * 1024 + kk) * 4 + ((n - 4) & 3)] : 0.f;
            const unsigned hb = f2bf(v); const float lo = v - __builtin_bit_cast(float, hb << 16);
            WRS[e] = (bf16_t)hb; WRS[32 * 1024 + e] = (bf16_t)f2bf(lo); }
    }
    {
        float* CS = (float*)(F.ws + WS_CS);
        for (int e = F.bid * 512 + F.tid; e < 2048 * 32; e += F.G * 512) { const int pos = e >> 5, i = e & 31;
            const float inv_freq = powf(10000.0f, -((float)(2 * i) / 64.0f)); const float ang = (float)pos * inv_freq;
            CS[2 * e] = cosf(ang); CS[2 * e + 1] = sinf(ang); }
    }
    {
        float* b1part = (float*)(F.ws + WS_MISC);
        for (int u = spread ? (F.bid + F.G - 216) % F.G : F.bid; u < 32; u += F.G) { const int kv = u >> 4, sl = u & 15; const float* pos = kv ? INP(16) : INP(11); const float* w1 = kv ? INP(17) : INP(12);
            if (F.tid < 256) { float acc = 0.f; for (int k = sl * 128; k < sl * 128 + 128; ++k) acc += pos[k] * w1[(size_t)k * 256 + F.tid]; b1part[(kv * 16 + sl) * 256 + F.tid] = acc; } }
    }
    {
        bf16_t* WaT = (bf16_t*)(F.ws + WS_WAIT); bf16_t* WiT = WaT + 16 * 64 * 64;
        for (int it = spread ? (gw + NGW - 1984) % NGW : gw; it < 2 * 16; it += NGW) { const int which = it >> 4, hb = it & 15;
            SrcPlain s{(which ? INP(7) : INP(5)) + (size_t)hb * 64 * 64, 64};
            transpose_tile(s, 64, (which ? WiT : WaT) + (size_t)hb * 64 * 64, 1, scr, 0, F.lane); }
    }
}

enum { PH_PRO = 0, PH_PROJ, PH_MID, PH_MIX, PH_YAB, PH_MIXOUT, PH_ROUTE, PH_MOE1, PH_MOE2, PH_FINAL, PH_COUNT };

template <bool COOP>
__device__ __forceinline__ void mk_body(const Args& args, unsigned char* lds_raw) {
    if (threadIdx.x == 0) {
        LAS unsigned long long* pt = (LAS unsigned long long*)((LAS unsigned char*)lds_raw + PTAB_OFF);
#pragma unroll
        for (int k = 0; k < 32; ++k) pt[k] = (unsigned long long)args.in[k];
        pt[32] = (unsigned long long)args.out; pt[33] = (unsigned long long)args.ws;
        ((LAS unsigned*)((LAS unsigned char*)lds_raw + XBST_OFF))[0] = 0u; ((LAS unsigned*)((LAS unsigned char*)lds_raw + XBST_OFF))[1] = 0u;
    }
    __syncthreads();
    XcdBarrier bar; bar.bar = nullptr; bar.x = 0; bar.st = nullptr;
    if (COOP) bar = xcd_barrier_post((unsigned*)(args.ws + WS_BAR), (volatile LAS unsigned*)((LAS unsigned char*)lds_raw + XBST_OFF));
    const int lo = args.ph_lo, hi = args.ph_hi;
#define IN(k) (lo <= (k) && (k) < hi)
#define SEAM(k) do { if (COOP && IN(k) && IN((k) + 1)) { xcd_barrier(bar); } } while (0)
    constexpr int PRE_OFF = TAB_BASE;
#ifndef DUP_PH
#define DUP_PH (-1)
#define DUP_N 0
#endif
#define REPS(k) for (int rep = (COOP && DUP_PH == (k)) ? DUP_N : 0; rep >= 0; --rep)
#define REPSEAM() do { if (rep > 0) xcd_barrier(bar); } while (0)
    if (IN(PH_PRO)) REPS(PH_PRO) { Frame F = make_frame(lds_raw); pro_phase(F, (bf16_t*)P_OUT); REPSEAM(); }
    SEAM(PH_PRO);
    if (IN(PH_PROJ)) REPS(PH_PROJ) { Frame F = make_frame(lds_raw); proj_phase(F, (const bf16_t*)P_OUT);
        if (F.G == 256 && F.bid >= 192) { __syncthreads(); conv_w1e(F, INP(28), INP(29), (bf16_t*)((unsigned char*)P_OUT + OUT_W1E), 0, W1E_EARLY, (F.bid - 192) * 8 + F.wave, 512); }
        REPSEAM(); }
    SEAM(PH_PROJ);
    if (IN(PH_MID)) REPS(PH_MID) {
      for (int mstep = 0; mstep < 2; ++mstep) {
        if ((mstep ^ (int)(blockIdx.x & 1)) == 0) { Frame F = make_frame(lds_raw);
          CmpPtrs CP{(const bf16_t*)(F.ws + WS_KV), (const bf16_t*)(F.ws + WS_KV + 8 * MiB), (const bf16_t*)(F.ws + WS_W1TK), (const bf16_t*)(F.ws + WS_W1TV), (const bf16_t*)(F.ws + WS_W2T), (const bf16_t*)(F.ws + WS_W2T) + 64 * 256,
                     INP(13), INP(18), (const float*)(F.ws + WS_MISC), INP(15), INP(20), (const float*)(F.ws + WS_CS), (bf16_t*)(F.ws + WS_KCMP), (bf16_t*)(F.ws + WS_VCMP), NB, (COOP && DUP_PH != PH_MID && DUP_PH != PH_MIX) ? (unsigned*)(F.ws + WS_RDY3) : nullptr};
          cmp_phase(F, CP); }
        else { Frame F = make_frame(lds_raw);
          LruPtrs LP{(const bf16_t*)(F.ws + WS_XR), (const bf16_t*)(F.ws + WS_GG), rep > 0 ? (bf16_t*)P_OUT : (bf16_t*)(F.ws + WS_GG), INP(3), INP(4), INP(6), INP(8), INP(9), (const bf16_t*)(F.ws + WS_WAIT), (const bf16_t*)(F.ws + WS_WAIT) + 16 * 64 * 64, (float*)(F.ws + WS_AGG), NB, (COOP && DUP_PH < 0) ? (unsigned*)(F.ws + WS_RDY4 + 1024) : nullptr};
          lru_seq_phase(F, LP); }
      }
        REPSEAM();
    }
    if (!(COOP && DUP_PH != PH_MID && DUP_PH != PH_MIX)) { SEAM(PH_MID); }
    if (IN(PH_MIX)) REPS(PH_MIX) {
        { Frame F = make_frame(lds_raw);
          AttnPtrs AP{(const bf16_t*)(F.ws + WS_Q), (const bf16_t*)(F.ws + WS_KV + 16 * MiB), (const bf16_t*)(F.ws + WS_KV + 24 * MiB), (const bf16_t*)(F.ws + WS_KV + 32 * MiB), (const bf16_t*)(F.ws + WS_KV + 40 * MiB),
                      (const bf16_t*)(F.ws + WS_KCMP), (const bf16_t*)(F.ws + WS_VCMP), (const float*)(F.ws + WS_NG), rep > 0 ? (bf16_t*)P_OUT : (bf16_t*)(F.ws + WS_Q), NB, (COOP && DUP_PH != PH_MID && DUP_PH != PH_MIX) ? (unsigned*)(F.ws + WS_RDY3) : nullptr, (COOP && DUP_PH < 0) ? (unsigned*)(F.ws + WS_RDY4) : nullptr};
#if defined(DUP_SKIP_ATTN)
          if (rep == 0)
#endif
#if defined(DUP_MODE)
          attn_phase(F, AP, rep > 0 ? DUP_MODE : 0); }
#else
          attn_phase(F, AP); }
#endif
        REPSEAM();
    }
    if (!(COOP && DUP_PH < 0)) { SEAM(PH_MIX); }
    if (IN(PH_YAB)) REPS(PH_YAB) { Frame F = make_frame(lds_raw); yab_phase(F, (const bf16_t*)(F.ws + WS_GG), (const bf16_t*)(F.ws + WS_WRNT), (const bf16_t*)(F.ws + WS_MG), (bf16_t*)(F.ws + WS_M), T, (COOP && DUP_PH < 0) ? (unsigned*)(F.ws + WS_RDY4) : nullptr, (COOP && DUP_PH < 0) ? (unsigned*)(F.ws + WS_RDY4 + 1024) : nullptr); REPSEAM(); }
    SEAM(PH_YAB);
    if (IN(PH_MIXOUT)) REPS(PH_MIXOUT) { Frame F = make_frame(lds_raw); mixout_phase(F, (const bf16_t*)(F.ws + WS_M), (const bf16_t*)(F.ws + WS_WMT), INP(0), (bf16_t*)(F.ws + WS_X1B), T, (COOP && DUP_PH != PH_MIXOUT && DUP_PH != PH_ROUTE) ? (unsigned*)(F.ws + WS_RDY2) : nullptr); REPSEAM(); }
    if (!(COOP && DUP_PH != PH_MIXOUT && DUP_PH != PH_ROUTE)) { SEAM(PH_MIXOUT); }
    if (IN(PH_ROUTE)) REPS(PH_ROUTE) { Frame F = make_frame(lds_raw);
        route_phase(F, (const bf16_t*)(F.ws + WS_X1B), INP(23), INP(24), INP(25), INP(26), INP(27), INP(28), INP(29), INP(30), (bf16_t*)((unsigned char*)P_OUT + OUT_W1E), (COOP && DUP_PH != PH_MIXOUT && DUP_PH != PH_ROUTE) ? (unsigned*)(F.ws + WS_RDY2) : nullptr);
        if (rep > 0) { xcd_barrier(bar); if (F.bid == 0 && F.tid < 16) ((unsigned*)(F.ws + WS_GCNT))[F.tid] = 0u; xcd_barrier(bar); }
    }
    SEAM(PH_ROUTE);
    if (IN(PH_MOE1)) REPS(PH_MOE1) { Frame F = make_frame(lds_raw);
        moe_prefix(F, (LAS int*)(F.lds + PRE_OFF));
        MoeSched Sc{(const LAS int*)(F.lds + PRE_OFF), F.G, F.bid, 4, 0, nullptr};
        GatherA AO{(const unsigned*)(F.ws + WS_LIST), (const unsigned*)(F.ws + WS_GCNT)};
        EpiMoe1 E{(bf16_t*)(F.ws + WS_ACT), (unsigned*)(F.ws + WS_RDY)};
        gemm_phase<EpiMoe1, MoeSched, GatherA, true>(F.lds, (const bf16_t*)(F.ws + WS_H2), (const bf16_t*)((const unsigned char*)P_OUT + OUT_W1E), 1024, Sc, E, AO);
        REPSEAM();
    }
    if (!COOP) { SEAM(PH_MOE1); }
    if (IN(PH_MOE2)) REPS(PH_MOE2) { Frame F = make_frame(lds_raw);
        moe_prefix(F, (LAS int*)(F.lds + PRE_OFF));
        MoeSched Sc{(const LAS int*)(F.lds + PRE_OFF), F.G, F.bid, 4, COOP ? 1 : 0, COOP ? (unsigned*)(F.ws + WS_RDY) : nullptr};
        DenseAct AO{1024u};
        EpiMoe2 E{(bf16_t*)(F.ws + WS_Y0), (bf16_t*)(F.ws + WS_Y1), (const unsigned*)(F.ws + WS_LIST), (const unsigned*)(F.ws + WS_GCNT), (const float*)(F.ws + WS_WSL)};
        gemm_phase<EpiMoe2, MoeSched, DenseAct, true>(F.lds, (const bf16_t*)(F.ws + WS_ACT), (const bf16_t*)(F.ws + WS_WDT), 512, Sc, E, AO);
        REPSEAM();
    }
    SEAM(PH_MOE2);
    if (IN(PH_FINAL)) REPS(PH_FINAL) { Frame F = make_frame(lds_raw);
        final_phase(F, (const bf16_t*)(F.ws + WS_X1B), rep > 0 ? (float*)(F.ws + WS_KV) : P_OUT, INP(31));
        REPSEAM();
    }
#undef REPS
#undef REPSEAM
#undef IN
#undef SEAM
}
__global__ void __launch_bounds__(512, 2) mk_fwd(Args args) {
    extern __shared__ __attribute__((aligned(16))) unsigned char lds_raw[];
    mk_body<MK_COOP != 0>(args, lds_raw);
}
}

extern "C" void kernel_launch(void* const* d_in, const int* in_sizes, int n_in, void* d_out, int out_size, void* d_ws, size_t ws_size, hipStream_t stream) {
    if (n_in != 32 || ws_size < 256 * mk::MiB || out_size != mk::T * mk::D) { fprintf(stderr, "kernel_launch: unexpected problem (n_in %d, out %d, ws %zu)\n", n_in, out_size, ws_size); return; }
    static int grid = 0;
    if (grid == 0) {
        if (hipFuncSetAttribute((const void*)mk::mk_fwd, hipFuncAttributeMaxDynamicSharedMemorySize, mk::LDS_BYTES) != hipSuccess) { fprintf(stderr, "kernel_launch: hipFuncSetAttribute failed\n"); grid = -1; return; }
        int dev = 0, cus = 0, per_cu = 0;
        (void)hipGetDevice(&dev); (void)hipDeviceGetAttribute(&cus, hipDeviceAttributeMultiprocessorCount, dev);
        (void)hipOccupancyMaxActiveBlocksPerMultiprocessor(&per_cu, (const void*)mk::mk_fwd, 512, mk::LDS_BYTES);
        if (per_cu < 1 || cus < 256) { fprintf(stderr, "kernel_launch: occupancy %d blocks/CU, %d CUs\n", per_cu, cus); }
        grid = 256;
    }
    if (grid < 0) return;
    mk::Args a{};
    for (int i = 0; i < 32; ++i) a.in[i] = (const float*)d_in[i];
    a.out = (float*)d_out; a.ws = (unsigned char*)d_ws;
#if MK_COOP
    if (hipMemsetAsync((char*)d_ws, 0, 32 * 1024, stream) != hipSuccess) { fprintf(stderr, "kernel_launch: memset failed\n"); return; }
    a.ph_lo = 0; a.ph_hi = mk::PH_COUNT;
    void* kargs[] = {&a};
    const hipError_t e = hipLaunchCooperativeKernel((const void*)mk::mk_fwd, dim3(grid), dim3(512), kargs, mk::LDS_BYTES, stream);
    if (e != hipSuccess) fprintf(stderr, "kernel_launch: cooperative launch failed: %s\n", hipGetErrorString(e));
#else
    for (int ph = 0; ph < mk::PH_COUNT; ++ph) { a.ph_lo = ph; a.ph_hi = ph + 1; hipLaunchKernelGGL(mk::mk_fwd, dim3(grid), dim3(512), mk::LDS_BYTES, stream, a); }
#endif
}
```
